# Optimizing an MI355X kernel written in HIP

```python
import jax, jax.numpy as jnp
from jax import lax
import numpy as np

D_MODEL = 2048
BATCH = 8
SEQ = 2048
DEPTH = 1

MIX_WIDTH = D_MODEL
FOURIER_WIDTH = D_MODEL // 4
FOURIER_GROUPS = 4
FOURIER_GROUP_DIM = FOURIER_WIDTH // FOURIER_GROUPS
RWKV_WIDTH = MIX_WIDTH - FOURIER_WIDTH
RWKV_HEAD_DIM = 64
RWKV_HEADS = RWKV_WIDTH // RWKV_HEAD_DIM
DECAY_LORA = 64
ICLR_LORA = 64
GATE_LORA = 224
D_FF = -(-8 * D_MODEL // (3 * 256)) * 256
ALPHA = (2.0 * DEPTH) ** 0.25
BETA = (8.0 * DEPTH) ** -0.25
LN_EPS = 1e-5
GN_EPS = 64e-5

F_OFF = 0
R_OFF = F_OFF + FOURIER_WIDTH
K_OFF = R_OFF + RWKV_WIDTH
V_OFF = K_OFF + RWKV_WIDTH
G_OFF = V_OFF + RWKV_WIDTH
WF_OFF = G_OFF + GATE_LORA
WB_OFF = WF_OFF + DECAY_LORA
AF_OFF = WB_OFF + DECAY_LORA
AB_OFF = AF_OFF + ICLR_LORA
IN_COLS = AB_OFF + ICLR_LORA
SHIFT_COLS = IN_COLS - R_OFF

kernel_name = "fnet_rwkv7_hybrid_deepnorm_block"


def _layernorm(x, g, b):
    xf = x.astype(jnp.float32)
    mu = jnp.mean(xf, -1, keepdims=True)
    var = jnp.mean(jnp.square(xf - mu), -1, keepdims=True)
    return ((xf - mu) * lax.rsqrt(var + LN_EPS)).astype(x.dtype) * g + b


def _centred_shift(p):
    z = jnp.zeros_like(p[:, :1])
    prev = jnp.concatenate([z, p[:, :-1]], axis=1)
    nxt = jnp.concatenate([p[:, 1:], z], axis=1)
    return 0.5 * (prev + nxt)


def _fourier_mixer(u):
    B, S, _ = u.shape
    ug = u.reshape(B, S, FOURIER_GROUPS, FOURIER_GROUP_DIM).astype(jnp.float32)
    f = jnp.fft.fft2(ug, axes=(1, 3), norm="ortho").real
    return f.reshape(B, S, FOURIER_WIDTH).astype(u.dtype)


def _wkv_scan(r, w, k, v, a, b):
    Bn, H2, N = r.shape[1:]

    def step(state, inp):
        r_t, w_t, k_t, v_t, a_t, b_t = inp
        sa = jnp.einsum('bhij,bhj->bhi', state, a_t)
        state = (state * w_t[:, :, None, :] + sa[..., None] * b_t[:, :, None, :]
                 + v_t[..., None] * k_t[:, :, None, :])
        y_t = jnp.einsum('bhij,bhj->bhi', state, r_t)
        return state, y_t

    s0 = jnp.zeros((Bn, H2, N, N), jnp.float32)
    _, y = lax.scan(step, s0, (r, w, k, v, a, b))
    return y


def _rwkv7_bidir(p, mu_shift, w_up_f, w_up_b, w0_f, w0_b, a_up_f, a_up_b, a0_f, a0_b,
                 g_up, k_k, k_a, r_k, lnx_g, lnx_b):
    B, S, _ = p.shape
    H, N = RWKV_HEADS, RWKV_HEAD_DIM
    p = p + (_centred_shift(p) - p) * mu_shift
    o = lambda off, n: p[..., off - R_OFF: off - R_OFF + n]
    r, k, v = o(R_OFF, RWKV_WIDTH), o(K_OFF, RWKV_WIDTH), o(V_OFF, RWKV_WIDTH)
    g = jax.nn.sigmoid(o(G_OFF, GATE_LORA)) @ g_up

    def decay(wd, up, w0):
        wl = -jax.nn.softplus(-(w0 + jnp.tanh(wd) @ up)) - 0.5
        return jnp.exp(-jnp.exp(wl.astype(jnp.float32)))

    w_f = decay(o(WF_OFF, DECAY_LORA), w_up_f, w0_f)
    w_b = decay(o(WB_OFF, DECAY_LORA), w_up_b, w0_b)
    a_f = jax.nn.sigmoid(a0_f + o(AF_OFF, ICLR_LORA) @ a_up_f)
    a_b = jax.nn.sigmoid(a0_b + o(AB_OFF, ICLR_LORA) @ a_up_b)

    heads = lambda t: t.reshape(B, S, H, N)
    kk = heads(k * k_k).astype(jnp.float32)
    kk = kk / jnp.maximum(jnp.linalg.norm(kk, axis=-1, keepdims=True), 1e-12)
    k_f = k * (1.0 + (a_f - 1.0) * k_a)
    k_b = k * (1.0 + (a_b - 1.0) * k_a)

    flip = lambda t: jnp.flip(t, axis=1)
    f32 = lambda t: heads(t).astype(jnp.float32)

    def both(tf, tb):
        return jnp.swapaxes(jnp.concatenate([tf, flip(tb)], axis=2), 0, 1)

    y = _wkv_scan(both(f32(r), f32(r)), both(f32(w_f), f32(w_b)), both(f32(k_f), f32(k_b)),
                  both(f32(v), f32(v)), both(-kk, -kk),
                  both(kk * f32(a_f), kk * f32(a_b)))
    y = jnp.swapaxes(y, 0, 1)
    y = y[:, :, :H] + flip(y[:, :, H:])
    mu = jnp.mean(y, -1, keepdims=True)
    var = jnp.mean(jnp.square(y - mu), -1, keepdims=True)
    y = ((y - mu) * lax.rsqrt(var + GN_EPS)).reshape(B, S, RWKV_WIDTH).astype(p.dtype)
    y = y * lnx_g + lnx_b
    bonus = jnp.sum(heads(r) * heads(k_f + k_b) * r_k, -1, keepdims=True) * heads(v)
    return (y + bonus.reshape(B, S, RWKV_WIDTH)) * g


def setup_inputs(seed: int = 0) -> dict:
    key = jax.random.key(seed)
    ks = iter(jax.random.split(key, 32))
    L, D, RW = DEPTH, D_MODEL, RWKV_WIDTH
    nrm = lambda shape, scale: jax.random.normal(next(ks), shape, jnp.float32) * scale
    uni = lambda shape, lo, hi: jax.random.uniform(next(ks), shape, jnp.float32, lo, hi)
    x = nrm((BATCH, SEQ, D), 1.0)
    w_in = nrm((L, D, IN_COLS), D ** -0.5)
    w_in = w_in.at[:, :, V_OFF:V_OFF + RW].multiply(BETA)
    return {
        "x": x,
        "w_in": w_in,
        "mu_shift": uni((L, SHIFT_COLS), 0.0, 1.0),
        "w_up_f": nrm((L, DECAY_LORA, RW), 0.1 * DECAY_LORA ** -0.5),
        "w_up_b": nrm((L, DECAY_LORA, RW), 0.1 * DECAY_LORA ** -0.5),
        "w0_f": uni((L, RW), -5.0, 0.0),
        "w0_b": uni((L, RW), -5.0, 0.0),
        "a_up_f": nrm((L, ICLR_LORA, RW), ICLR_LORA ** -0.5),
        "a_up_b": nrm((L, ICLR_LORA, RW), ICLR_LORA ** -0.5),
        "a0_f": nrm((L, RW), 0.1),
        "a0_b": nrm((L, RW), 0.1),
        "g_up": nrm((L, GATE_LORA, RW), GATE_LORA ** -0.5),
        "k_k": 0.85 + nrm((L, RW), 0.02),
        "k_a": 1.0 + nrm((L, RW), 0.02),
        "r_k": nrm((L, RWKV_HEADS, RWKV_HEAD_DIM), 0.1),
        "lnx_g": 1.0 + nrm((L, RW), 0.02),
        "lnx_b": nrm((L, RW), 0.02),
        "w_out": nrm((L, MIX_WIDTH, D), BETA * MIX_WIDTH ** -0.5),
        "ln1_g": 1.0 + nrm((L, D), 0.02),
        "ln1_b": nrm((L, D), 0.02),
        "w_ffn_gate": nrm((L, D, D_FF), BETA * D ** -0.5),
        "w_ffn_up": nrm((L, D, D_FF), BETA * D ** -0.5),
        "w_ffn_down": nrm((L, D_FF, D), BETA * D_FF ** -0.5),
        "ln2_g": 1.0 + nrm((L, D), 0.02),
        "ln2_b": nrm((L, D), 0.02),
    }


def reference(x, w_in, mu_shift, w_up_f, w_up_b, w0_f, w0_b, a_up_f, a_up_b, a0_f, a0_b,
              g_up, k_k, k_a, r_k, lnx_g, lnx_b, w_out, ln1_g, ln1_b,
              w_ffn_gate, w_ffn_up, w_ffn_down, ln2_g, ln2_b):
    for l in range(DEPTH):
        proj = jnp.einsum('bsd,dc->bsc', x, w_in[l])
        y_fourier = _fourier_mixer(proj[..., F_OFF:R_OFF])
        y_rwkv = _rwkv7_bidir(proj[..., R_OFF:], mu_shift[l], w_up_f[l], w_up_b[l],
                              w0_f[l], w0_b[l], a_up_f[l], a_up_b[l], a0_f[l], a0_b[l],
                              g_up[l], k_k[l], k_a[l], r_k[l], lnx_g[l], lnx_b[l])
        mix = jnp.einsum('bsc,cd->bsd', jnp.concatenate([y_fourier, y_rwkv], -1), w_out[l])
        h = _layernorm(ALPHA * x + mix, ln1_g[l], ln1_b[l])
        ff = jax.nn.silu(h @ w_ffn_gate[l]) * (h @ w_ffn_up[l])
        x = _layernorm(ALPHA * h + ff @ w_ffn_down[l], ln2_g[l], ln2_b[l])
    return x
```

```cpp
#include <hip/hip_runtime.h>
#include <hip/hip_cooperative_groups.h>
#include <cstdio>
#include <cstdint>
namespace cg = cooperative_groups;

#ifndef N_LAUNCH_MODE
#define N_LAUNCH_MODE 1
#endif

#define LAS __attribute__((address_space(3)))
typedef unsigned short bf16_t;
typedef short bf16x8 __attribute__((ext_vector_type(8)));
typedef float f32x4 __attribute__((ext_vector_type(4)));
typedef float f32x2 __attribute__((ext_vector_type(2)));
typedef unsigned u32x4 __attribute__((ext_vector_type(4)));
typedef unsigned u32x2 __attribute__((ext_vector_type(2)));

constexpr int NTOK = 16384, DM = 2048, SEQ = 2048, NB = 8;
constexpr int INP = 5632;
constexpr int RW = 1536, NH = 24;
constexpr int R_OFF = 512, K_OFF = 2048, V_OFF = 3584, G_OFF = 5120;
constexpr int DFF = 5632;
constexpr float ALPHA = 1.189207115002721f;
constexpr float LN_EPS = 1e-5f, GN_EPS = 64e-5f;

constexpr size_t MiB = 1048576;
constexpr size_t WS_RA    = 0;
constexpr size_t WS_XB    = WS_RA;
constexpr size_t WS_WINT  = 88 * MiB + 176 * MiB;
constexpr size_t WS_AMIX  = WS_RA;
constexpr size_t WS_DFTM  = WS_RA + 64 * MiB;
constexpr size_t WS_WOUTT = WS_RA + 80 * MiB;
constexpr size_t WS_WGUT  = WS_RA;
constexpr size_t WS_PROJ  = 88 * MiB;
constexpr size_t WS_FFA   = WS_PROJ;
constexpr size_t WS_OUT5  = WS_PROJ + 176 * MiB;
constexpr size_t WS_H     = WS_OUT5;
constexpr size_t WS_HB    = WS_OUT5 + 128 * MiB;
constexpr size_t WS_SMALL = WS_OUT5 + 240 * MiB;
constexpr size_t WS_WLT   = WS_SMALL;
constexpr size_t WS_CDFT  = WS_SMALL + 4 * MiB;
constexpr size_t WS_BIAS  = WS_SMALL + 5 * MiB;
constexpr size_t WS_BAR   = WS_BIAS + 65536;
constexpr size_t WS_END   = WS_SMALL + 6 * MiB;
constexpr size_t DO_Y = 0, DO_WDNT = 48 * MiB, DO_FABT = 96 * MiB, DO_ALORA = 0;
constexpr size_t OUT5_STRIDE = (size_t)NTOK * RW;

struct Args {
    const float* in[25];
    float* out;
    unsigned char* ws;
    int ph_lo, ph_hi;
};

typedef __bf16 bf16v2 __attribute__((ext_vector_type(2)));
__device__ __forceinline__ unsigned cvt_pk_bf16(float lo, float hi) { const f32x2 v = {lo, hi}; return __builtin_bit_cast(unsigned, __builtin_convertvector(v, bf16v2)); }
__device__ __forceinline__ float bf2f(bf16_t h) { return __uint_as_float(((unsigned)h) << 16); }
__device__ __forceinline__ bf16_t f2bf(float f) { return (bf16_t)(cvt_pk_bf16(f, 0.f) & 0xffffu); }
__device__ __forceinline__ float wave_sum(float v) {
#pragma unroll
    for (int o = 1; o < 64; o <<= 1) v += __shfl_xor(v, o);
    return v;
}
__device__ __forceinline__ float wave_sum_dpp(float v) {
    v += __builtin_bit_cast(float, __builtin_amdgcn_update_dpp(0, __builtin_bit_cast(int, v), 0xB1, 0xf, 0xf, true));
    v += __builtin_bit_cast(float, __builtin_amdgcn_update_dpp(0, __builtin_bit_cast(int, v), 0x4E, 0xf, 0xf, true));
    v += __builtin_bit_cast(float, __builtin_amdgcn_update_dpp(0, __builtin_bit_cast(int, v), 0x141, 0xf, 0xf, true));
    v += __builtin_bit_cast(float, __builtin_amdgcn_update_dpp(0, __builtin_bit_cast(int, v), 0x140, 0xf, 0xf, true));
    v += __builtin_bit_cast(float, __builtin_amdgcn_update_dpp(0, __builtin_bit_cast(int, v), 0x142, 0xa, 0xf, false));
    v += __builtin_bit_cast(float, __builtin_amdgcn_update_dpp(0, __builtin_bit_cast(int, v), 0x143, 0xc, 0xf, false));
    return __builtin_bit_cast(float, __builtin_amdgcn_readlane(__builtin_bit_cast(int, v), 63));
}
__device__ __forceinline__ float sigmoidf_(float z) { return __builtin_amdgcn_rcpf(1.0f + __expf(-z)); }
#define LDS_WAIT() asm volatile("s_waitcnt lgkmcnt(0)" ::: "memory")
#define RAW_BARRIER() do { asm volatile("s_waitcnt lgkmcnt(0)" ::: "memory"); __builtin_amdgcn_s_barrier(); asm volatile("" ::: "memory"); } while (0)
constexpr int INP_ = 5632, SEQ_ = 2048;
__device__ __forceinline__ float shifted(const bf16_t* p, int t, float mu) {
    const float fp = t > 0 ? 1.0f : 0.0f, fn = t < SEQ_ - 1 ? 1.0f : 0.0f;
    const bf16_t* q0 = t > 0 ? p - INP_ : p; const bf16_t* q1 = t < SEQ_ - 1 ? p + INP_ : p;
    const float p0 = bf2f(p[0]), pp = bf2f(q0[0]) * fp, pn = bf2f(q1[0]) * fn;
    return p0 + (0.5f * (pp + pn) - p0) * mu;
}


namespace pg8 {
constexpr int BM = 256, BK = 64, HALF = 128, HTB = HALF * BK * 2, STAGE_BYTES = 8 * HTB, NXCD = 8, WGM = 8;
__host__ __device__ __forceinline__ int lds_byte(int r, int c) { const int st = (r >> 4) * 2 + (c >> 5), rr = r & 15, cc = c & 31, ob = rr * 64 + cc * 2; return st * 1024 + (ob ^ (((ob >> 9) & 1) << 5)); }
__host__ __device__ __forceinline__ void stage_rc(int b, int& R, int& C) { const int st = b / 1024, sb = b % 1024, swz = sb ^ (((sb >> 9) & 1) << 5); R = (st >> 1) * 16 + swz / 64; C = (st & 1) * 32 + (swz % 64) / 2; }
__host__ __device__ __forceinline__ int perm32(int rho) { const int n = rho >> 4, i = rho & 15; return 8 * (i >> 2) + 4 * n + (i & 3); }
struct Unit { int pm, pn; };

template <int MODE> struct Order {
    int nM, nN, nwg, G, c;
    const char* A; const char* B; size_t tA, tB;
    __device__ void init(int M, int N, int G_, int c_, const void* A_, int lda, const void* B_, int ldb) {
        nM = M / BM; nN = N / BM; nwg = nM * nN; G = G_; c = c_; A = (const char*)A_; B = (const char*)B_; tA = (size_t)BM * lda * 2; tB = (size_t)BM * ldb * 2; }
    __device__ bool next(int i, Unit& u) const {
        const long L = (long)i * G + c; if (L >= nwg) return false;
        int wgid = (int)L; { const int q = nwg / NXCD, r = nwg % NXCD, xcd = wgid % NXCD, off = wgid / NXCD; wgid = (xcd < r ? xcd * (q + 1) : r * (q + 1) + (xcd - r) * q) + off; }
        const int nig = WGM * nN, gid = wgid / nig, fm = gid * WGM, gsz = (nM - fm) < WGM ? (nM - fm) : WGM;
        u.pm = fm + ((wgid % nig) % gsz); u.pn = (wgid % nig) / gsz; return true;
    }
    __device__ __forceinline__ const char* pa(const Unit& u) const {
        if (MODE == 1) return A + (size_t)u.pm * tA + (u.pn >= 24 ? 512 : 0);
        if (MODE == 3) return A + (size_t)u.pm * tA + (u.pn >= 12 ? 256 : 0);
        if (MODE == 2) return A + (size_t)(u.pm & 7) * tA;
        return A + (size_t)u.pm * tA; }
    __device__ __forceinline__ const char* pb(const Unit& u) const {
        if (MODE == 2) return B + (size_t)(u.pm >> 3) * ((size_t)512 * 4096 * 2) + (size_t)u.pn * tB;
        return B + (size_t)u.pn * tB; }
};

struct EpiBf16 {
    static constexpr bool PERM = true;
    bf16_t* O; int ldc;
    __device__ __forceinline__ void operator()(const f32x4 (&acc)[2][2][4][2], const Unit& u, int wr, int wc, int fr, int fq) const {
        const int row0 = u.pm * BM + wr * 64 + fr, col0 = u.pn * BM + wc * 32 + 8 * fq;
#pragma unroll
        for (int ai = 0; ai < 2; ++ai)
#pragma unroll
            for (int m = 0; m < 4; ++m) { bf16_t* rowp = O + (size_t)(row0 + ai * HALF + m * 16) * ldc + col0;
#pragma unroll
                for (int bj = 0; bj < 2; ++bj) { const f32x4 v0 = acc[ai][bj][m][0], v1 = acc[ai][bj][m][1];
                    u32x4 w; w.x = cvt_pk_bf16(v0[0], v0[1]); w.y = cvt_pk_bf16(v0[2], v0[3]); w.z = cvt_pk_bf16(v1[0], v1[1]); w.w = cvt_pk_bf16(v1[2], v1[3]);
                    *(u32x4*)(rowp + bj * HALF) = w; } }
    }
};
struct EpiLora {
    static constexpr bool PERM = true;
    bf16_t* O; const float* bias; int qoff;
    __device__ __forceinline__ void operator()(const f32x4 (&acc)[2][2][4][2], const Unit& u, int wr, int wc, int fr, int fq) const {
        const int q = u.pn / 6 + qoff, cb = (u.pn % 6) * BM + wc * 32 + 8 * fq;
        const int row0 = u.pm * BM + wr * 64 + fr;
        bf16_t* base = O + (size_t)q * OUT5_STRIDE + cb;
        const float* bp = bias + (q & 3) * RW + cb;
        const float sc = (q < 2) ? -0.6065306597126334f : 1.0f;
#pragma unroll
        for (int ai = 0; ai < 2; ++ai)
#pragma unroll
            for (int m = 0; m < 4; ++m) { bf16_t* rowp = base + (size_t)(row0 + ai * HALF + m * 16) * RW;
#pragma unroll
                for (int bj = 0; bj < 2; ++bj) { f32x4 v0 = acc[ai][bj][m][0], v1 = acc[ai][bj][m][1];
                    if (q < 4) { const f32x4 c0 = *(const f32x4*)(bp + bj * HALF), c1 = *(const f32x4*)(bp + bj * HALF + 4);
#pragma unroll
                        for (int j = 0; j < 4; ++j) { v0[j] = sc * sigmoidf_(v0[j] + c0[j]); v1[j] = sc * sigmoidf_(v1[j] + c1[j]); } }
                    u32x4 w; w.x = cvt_pk_bf16(v0[0], v0[1]); w.y = cvt_pk_bf16(v0[2], v0[3]); w.z = cvt_pk_bf16(v1[0], v1[1]); w.w = cvt_pk_bf16(v1[2], v1[3]);
                    *(u32x4*)(rowp + bj * HALF) = w; }
                asm volatile("" ::: "memory"); }
    }
};
struct EpiCdft {
    static constexpr bool PERM = true;
    bf16_t* O;
    __device__ __forceinline__ void operator()(const f32x4 (&acc)[2][2][4][2], const Unit& u, int wr, int wc, int fr, int fq) const {
        const int row0 = u.pm * BM + wr * 64 + fr, tok0 = u.pn * BM + wc * 32 + 8 * fq;
        const int b = tok0 >> 11, pos0 = tok0 & 2047;
#pragma unroll
        for (int ai = 0; ai < 2; ++ai)
#pragma unroll
            for (int m = 0; m < 4; ++m) { const int mm = row0 + ai * HALF + m * 16, part = mm >> 9, np = mm & 511;
                bf16_t* rowp = O + ((size_t)(b * 512 + np) * 4096 + part * 2048 + pos0);
#pragma unroll
                for (int bj = 0; bj < 2; ++bj) { const f32x4 v0 = acc[ai][bj][m][0], v1 = acc[ai][bj][m][1];
                    u32x4 w; w.x = cvt_pk_bf16(v0[0], v0[1]); w.y = cvt_pk_bf16(v0[2], v0[3]); w.z = cvt_pk_bf16(v1[0], v1[1]); w.w = cvt_pk_bf16(v1[2], v1[3]);
                    *(u32x4*)(rowp + bj * HALF) = w; } }
    }
};
struct EpiResF32 {
    static constexpr bool PERM = false;
    float* C; const float* res;
    __device__ __forceinline__ void operator()(const f32x4 (&acc)[2][2][4][2], const Unit& u, int wr, int wc, int fr, int fq) const {
        const int row0 = u.pm * BM + wr * 64 + fr, col0 = u.pn * BM + wc * 32 + 4 * fq;
#pragma unroll
        for (int ai = 0; ai < 2; ++ai)
#pragma unroll
            for (int m = 0; m < 4; ++m) { const size_t off = (size_t)(row0 + ai * HALF + m * 16) * DM + col0;
#pragma unroll
                for (int bj = 0; bj < 2; ++bj)
#pragma unroll
                    for (int n = 0; n < 2; ++n) { const f32x4 rs = *(const f32x4*)(res + off + bj * HALF + n * 16); *(f32x4*)(C + off + bj * HALF + n * 16) = acc[ai][bj][m][n] + ALPHA * rs; }
                asm volatile("" ::: "memory"); }
    }
};
struct EpiResToBf16 {
    static constexpr bool PERM = true;
    bf16_t* O; const float* res;
    __device__ __forceinline__ void operator()(const f32x4 (&acc)[2][2][4][2], const Unit& u, int wr, int wc, int fr, int fq) const {
        const int row0 = u.pm * BM + wr * 64 + fr, col0 = u.pn * BM + wc * 32 + 8 * fq;
#pragma unroll
        for (int ai = 0; ai < 2; ++ai)
#pragma unroll
            for (int m = 0; m < 4; ++m) { const size_t off = (size_t)(row0 + ai * HALF + m * 16) * DM + col0;
#pragma unroll
                for (int bj = 0; bj < 2; ++bj) { const f32x4 r0 = *(const f32x4*)(res + off + bj * HALF), r1 = *(const f32x4*)(res + off + bj * HALF + 4);
                    const f32x4 v0 = acc[ai][bj][m][0] + ALPHA * r0, v1 = acc[ai][bj][m][1] + ALPHA * r1;
                    u32x4 w; w.x = cvt_pk_bf16(v0[0], v0[1]); w.y = cvt_pk_bf16(v0[2], v0[3]); w.z = cvt_pk_bf16(v1[0], v1[1]); w.w = cvt_pk_bf16(v1[2], v1[3]);
                    *(u32x4*)(O + off + bj * HALF) = w; }
                asm volatile("" ::: "memory"); }
    }
};
struct EpiResBfToBf {
    static constexpr bool PERM = true;
    bf16_t* O; const bf16_t* res;
    __device__ __forceinline__ void operator()(const f32x4 (&acc)[2][2][4][2], const Unit& u, int wr, int wc, int fr, int fq) const {
        const int row0 = u.pm * BM + wr * 64 + fr, col0 = u.pn * BM + wc * 32 + 8 * fq;
#pragma unroll
        for (int ai = 0; ai < 2; ++ai)
#pragma unroll
            for (int m = 0; m < 4; ++m) { const size_t off = (size_t)(row0 + ai * HALF + m * 16) * DM + col0;
#pragma unroll
                for (int bj = 0; bj < 2; ++bj) { const u32x4 rb = *(const u32x4*)(res + off + bj * HALF);
                    const f32x4 r0 = {__uint_as_float(rb.x << 16), __uint_as_float(rb.x & 0xffff0000u), __uint_as_float(rb.y << 16), __uint_as_float(rb.y & 0xffff0000u)};
                    const f32x4 r1 = {__uint_as_float(rb.z << 16), __uint_as_float(rb.z & 0xffff0000u), __uint_as_float(rb.w << 16), __uint_as_float(rb.w & 0xffff0000u)};
                    const f32x4 v0 = acc[ai][bj][m][0] + ALPHA * r0, v1 = acc[ai][bj][m][1] + ALPHA * r1;
                    u32x4 w; w.x = cvt_pk_bf16(v0[0], v0[1]); w.y = cvt_pk_bf16(v0[2], v0[3]); w.z = cvt_pk_bf16(v1[0], v1[1]); w.w = cvt_pk_bf16(v1[2], v1[3]);
                    *(u32x4*)(O + off + bj * HALF) = w; }
                asm volatile("" ::: "memory"); }
    }
};
struct EpiResBf16 {
    static constexpr bool PERM = false;
    float* C; const bf16_t* res;
    __device__ __forceinline__ void operator()(const f32x4 (&acc)[2][2][4][2], const Unit& u, int wr, int wc, int fr, int fq) const {
        const int row0 = u.pm * BM + wr * 64 + fr, col0 = u.pn * BM + wc * 32 + 4 * fq;
#pragma unroll
        for (int ai = 0; ai < 2; ++ai)
#pragma unroll
            for (int m = 0; m < 4; ++m) { const size_t off = (size_t)(row0 + ai * HALF + m * 16) * DM + col0;
#pragma unroll
                for (int bj = 0; bj < 2; ++bj)
#pragma unroll
                    for (int n = 0; n < 2; ++n) { const u32x2 rb = *(const u32x2*)(res + off + bj * HALF + n * 16);
                        const f32x4 rs = {__uint_as_float(rb.x << 16), __uint_as_float(rb.x & 0xffff0000u), __uint_as_float(rb.y << 16), __uint_as_float(rb.y & 0xffff0000u)};
                        *(f32x4*)(C + off + bj * HALF + n * 16) = acc[ai][bj][m][n] + ALPHA * rs; }
                asm volatile("" ::: "memory"); }
    }
};
struct EpiSwiglu {
    static constexpr bool PERM = true;
    bf16_t* O;
    __device__ __forceinline__ void operator()(const f32x4 (&acc)[2][2][4][2], const Unit& u, int wr, int wc, int fr, int fq) const {
        const int row0 = u.pm * BM + wr * 64 + fr, col0 = u.pn * HALF + wc * 32 + 8 * fq;
#pragma unroll
        for (int ai = 0; ai < 2; ++ai)
#pragma unroll
            for (int m = 0; m < 4; ++m) { bf16_t* rowp = O + (size_t)(row0 + ai * HALF + m * 16) * DFF + col0;
                f32x4 o0, o1;
#pragma unroll
                for (int j = 0; j < 4; ++j) { const float g0 = acc[ai][0][m][0][j], g1 = acc[ai][0][m][1][j];
                    o0[j] = g0 * sigmoidf_(g0) * acc[ai][1][m][0][j]; o1[j] = g1 * sigmoidf_(g1) * acc[ai][1][m][1][j]; }
                u32x4 w; w.x = cvt_pk_bf16(o0[0], o0[1]); w.y = cvt_pk_bf16(o0[2], o0[3]); w.z = cvt_pk_bf16(o1[0], o1[1]); w.w = cvt_pk_bf16(o1[2], o1[3]);
                *(u32x4*)rowp = w; }
    }
};

template <class Epi, class Sched>
__device__ __forceinline__ void gemm_phase(LAS unsigned char* lds, const int K, const int lda, const int ldb, const Sched& S, const Epi& E) {
    const int tid = threadIdx.x, wid = __builtin_amdgcn_readfirstlane(tid >> 6), lane = tid & 63, wr = wid >> 2, wc = wid & 3, fr = lane & 15, fq = lane >> 4;
    const int nt = K / BK;
    unsigned voffA[2], voffB[2];
#pragma unroll
    for (int i = 0; i < 2; ++i) { int R, C; stage_rc(tid * 16 + i * 8192, R, C); const int Rb = Epi::PERM ? ((R & ~31) + perm32(R & 31)) : R;
        voffA[i] = (unsigned)(R * lda + C) * 2u; voffB[i] = (unsigned)(Rb * ldb + C) * 2u; }
    const size_t kstep = (size_t)(BK * 2);
    const size_t hstepA = (size_t)HALF * lda * 2, hstepB = (size_t)HALF * ldb * 2;
    const unsigned ldsw = (unsigned)wid * 1024u;
    const int aoff = lds_byte(wr * 64 + fr, fq * 8), boff = lds_byte(wc * 32 + fr, fq * 8);
#define PG8_SA(b, h) (((b) * 2 + (h)) * HTB)
#define PG8_SB(b, h) ((4 + (b) * 2 + (h)) * HTB)
#define PG8_STAGE(bufoff, gbase, voff) do { _Pragma("unroll") for (int _i = 0; _i < 2; ++_i) \
        __builtin_amdgcn_global_load_lds((const unsigned*)((const char*)(gbase) + (voff)[_i]), (LAS unsigned*)(lds + (bufoff) + ldsw + _i * 8192), 16, 0, 0); } while (0)
#define PG8_LDA(dst, b, h) do { _Pragma("unroll") for (int m = 0; m < 4; ++m) _Pragma("unroll") for (int k = 0; k < 2; ++k) dst[m][k] = *(const LAS bf16x8*)(lds + PG8_SA(b, h) + aoff + m * 2048 + k * 1024); } while (0)
#define PG8_LDB(dst, b, h) do { _Pragma("unroll") for (int n = 0; n < 2; ++n) _Pragma("unroll") for (int k = 0; k < 2; ++k) dst[n][k] = *(const LAS bf16x8*)(lds + PG8_SB(b, h) + boff + n * 2048 + k * 1024); } while (0)
#define PG8_MMA(ai, bj, At, Bt) do { __builtin_amdgcn_s_setprio(1); _Pragma("unroll") for (int m = 0; m < 4; ++m) _Pragma("unroll") for (int n = 0; n < 2; ++n) _Pragma("unroll") for (int k = 0; k < 2; ++k) \
        acc[ai][bj][m][n] = __builtin_amdgcn_mfma_f32_16x16x32_bf16(Bt[n][k], At[m][k], acc[ai][bj][m][n], 0, 0, 0); __builtin_amdgcn_s_setprio(0); } while (0)
#define PG8_WAIT_V(n) asm volatile("s_waitcnt vmcnt(" #n ")" ::: "memory")
#define PG8_WAIT_L(n) asm volatile("s_waitcnt lgkmcnt(" #n ")" ::: "memory")
#define PG8_BAR __builtin_amdgcn_s_barrier()
#define PG8_SCHED __builtin_amdgcn_sched_barrier(0)
    Unit cur, nxt; int ui = 0;
    if (!S.next(0, cur)) return;
    f32x4 acc[2][2][4][2];
#pragma unroll
    for (int a = 0; a < 2; ++a)
#pragma unroll
        for (int b = 0; b < 2; ++b)
#pragma unroll
            for (int m = 0; m < 4; ++m)
#pragma unroll
                for (int n = 0; n < 2; ++n) acc[a][b][m][n] = (f32x4){0.f, 0.f, 0.f, 0.f};
    bf16x8 At[4][2], B0[2][2], B1[2][2];
    const char* cA = S.pa(cur); const char* cB = S.pb(cur);
    PG8_STAGE(PG8_SB(0, 0), cB, voffB); PG8_STAGE(PG8_SB(0, 1), cB + hstepB, voffB); PG8_STAGE(PG8_SA(0, 0), cA, voffA); PG8_STAGE(PG8_SA(0, 1), cA + hstepA, voffA);
    if (wr == 1) PG8_BAR;
    PG8_WAIT_V(2); PG8_BAR;
    PG8_STAGE(PG8_SB(1, 0), cB + kstep, voffB); PG8_STAGE(PG8_SA(1, 0), cA + kstep, voffA); PG8_STAGE(PG8_SB(1, 1), cB + hstepB + kstep, voffB);
    PG8_WAIT_V(6); PG8_BAR;
    for (;;) {
        const bool has_next = S.next(ui + 1, nxt);
        const char* nA = has_next ? S.pa(nxt) : cA; const char* nB = has_next ? S.pb(nxt) : cB;
        for (int t = 0; t < nt; t += 2) {
            const bool last = (t == nt - 2);
            const char* a1 = cA + (size_t)(t + 1) * kstep;
            const char* a2 = last ? nA : cA + (size_t)(t + 2) * kstep; const char* b2 = last ? nB : cB + (size_t)(t + 2) * kstep;
            const char* a3 = a2 + kstep; const char* b3 = b2 + kstep;
            PG8_LDB(B0, 0, 0); PG8_LDB(B1, 0, 1); PG8_SCHED; PG8_LDA(At, 0, 0); PG8_STAGE(PG8_SA(1, 1), a1 + hstepA, voffA);
            PG8_WAIT_V(8); PG8_WAIT_L(0); PG8_BAR; PG8_MMA(0, 0, At, B0); PG8_MMA(0, 1, At, B1); PG8_BAR; PG8_SCHED;
            PG8_LDA(At, 0, 1); PG8_STAGE(PG8_SB(0, 0), b2, voffB); PG8_STAGE(PG8_SB(0, 1), b2 + hstepB, voffB); PG8_STAGE(PG8_SA(0, 0), a2, voffA);
            PG8_WAIT_V(8); PG8_WAIT_L(0); PG8_BAR; PG8_MMA(1, 0, At, B0); PG8_MMA(1, 1, At, B1); PG8_BAR; PG8_SCHED;
            PG8_LDB(B0, 1, 0); PG8_LDB(B1, 1, 1); PG8_SCHED; PG8_LDA(At, 1, 0); PG8_STAGE(PG8_SA(0, 1), a2 + hstepA, voffA);
            PG8_WAIT_V(8); PG8_WAIT_L(0); PG8_BAR; PG8_MMA(0, 0, At, B0); PG8_MMA(0, 1, At, B1); PG8_BAR; PG8_SCHED;
            PG8_LDA(At, 1, 1); PG8_STAGE(PG8_SB(1, 0), b3, voffB); PG8_STAGE(PG8_SB(1, 1), b3 + hstepB, voffB); PG8_STAGE(PG8_SA(1, 0), a3, voffA);
            PG8_WAIT_V(8); PG8_WAIT_L(0); PG8_BAR; PG8_MMA(1, 0, At, B0); PG8_MMA(1, 1, At, B1); PG8_BAR; PG8_SCHED;
        }
        if (wr == 0) PG8_BAR;
        E(acc, cur, wr, wc, fr, fq);
        if (!has_next) break;
#pragma unroll
        for (int a = 0; a < 2; ++a)
#pragma unroll
            for (int b = 0; b < 2; ++b)
#pragma unroll
                for (int m = 0; m < 4; ++m)
#pragma unroll
                    for (int n = 0; n < 2; ++n) acc[a][b][m][n] = (f32x4){0.f, 0.f, 0.f, 0.f};
        cur = nxt; cA = nA; cB = nB; ++ui;
        if (wr == 1) PG8_BAR;
    }
    PG8_WAIT_V(0);
    PG8_BAR;
#undef PG8_SA
#undef PG8_SB
#undef PG8_STAGE
#undef PG8_LDA
#undef PG8_LDB
#undef PG8_MMA
#undef PG8_WAIT_V
#undef PG8_WAIT_L
#undef PG8_BAR
#undef PG8_SCHED
}
}

template <int MODE> __device__ __forceinline__ void tr_item(const float* W, int K, int N, bf16_t* WT, int ldd, LAS float* scr, int item, int lane) {
    const int nblk = N / 32, kb = item / nblk, nb = item % nblk, k0 = 64 * kb, n0 = 32 * nb;
    float tv[32];
#pragma unroll
    for (int i = 0; i < 32; ++i) tv[i] = W[(size_t)(k0 + 2 * i + (lane >> 5)) * N + n0 + (lane & 31)];
#pragma unroll
    for (int i = 0; i < 32; ++i) scr[(2 * i + (lane >> 5)) * 33 + (lane & 31)] = tv[i];
    LDS_WAIT();
    const int c = lane & 7;
#pragma unroll
    for (int j = 0; j < 4; ++j) { const int n = n0 + (lane >> 3) + 8 * j; const LAS float* s = scr + (8 * c) * 33 + (n - n0);
        u32x4 o; o.x = cvt_pk_bf16(s[0 * 33], s[1 * 33]); o.y = cvt_pk_bf16(s[2 * 33], s[3 * 33]); o.z = cvt_pk_bf16(s[4 * 33], s[5 * 33]); o.w = cvt_pk_bf16(s[6 * 33], s[7 * 33]);
        const int dr = (MODE == 0) ? n : (256 * (n >> 7) + (MODE == 2 ? 128 : 0) + (n & 127));
        *(u32x4*)(WT + (size_t)dr * ldd + k0 + 8 * c) = o; }
    LDS_WAIT();
}

struct Ctx {
    const Args& a; LAS unsigned char* lds; int lane, wave, bid, G, gw, NGW, gtid, GT;
    __device__ __forceinline__ Ctx(const Args& a_, LAS unsigned char* l) : a(a_), lds(l), lane(threadIdx.x & 63), wave(__builtin_amdgcn_readfirstlane(threadIdx.x >> 6)), bid(blockIdx.x), G(gridDim.x),
        gw(blockIdx.x * 8 + wave), NGW(gridDim.x * 8), gtid(blockIdx.x * 512 + threadIdx.x), GT(gridDim.x * 512) {}
};

__device__ __forceinline__ void phase0(const Ctx& c) {
    const float* x = c.a.in[0];
    bf16_t* xb = (bf16_t*)(c.a.ws + WS_XB);
    for (size_t i0 = c.gtid; i0 < (size_t)NTOK * DM / 8; i0 += (size_t)4 * c.GT) {
        f32x4 p[4], q[4];
#pragma unroll
        for (int u = 0; u < 4; ++u) { const size_t i = i0 + (size_t)u * c.GT; p[u] = ((const f32x4*)x)[2 * i]; q[u] = ((const f32x4*)x)[2 * i + 1]; }
#pragma unroll
        for (int u = 0; u < 4; ++u) { const size_t i = i0 + (size_t)u * c.GT;
            u32x4 o; o.x = cvt_pk_bf16(p[u][0], p[u][1]); o.y = cvt_pk_bf16(p[u][2], p[u][3]); o.z = cvt_pk_bf16(q[u][0], q[u][1]); o.w = cvt_pk_bf16(q[u][2], q[u][3]); ((u32x4*)xb)[i] = o; } }
    LAS float* scr = (LAS float*)(c.lds + c.wave * 16384);
    bf16_t* wint = (bf16_t*)(c.a.ws + WS_WINT);
    for (int it = c.gw; it < 32 * 175; it += c.NGW) tr_item<0>(c.a.in[1], DM, 5600, wint, DM, scr, it, c.lane);
    for (int i = c.gtid; i < 32 * DM / 8; i += c.GT) ((u32x4*)(wint + (size_t)5600 * DM))[i] = (u32x4){0u, 0u, 0u, 0u};
}

__device__ __forceinline__ void phase2(const Ctx& c) {
    const bf16_t* proj = (const bf16_t*)(c.a.ws + WS_PROJ);
    bf16_t* al = (bf16_t*)((unsigned char*)c.a.out + DO_ALORA);
    const float* mu = c.a.in[2];
    for (int i = c.gtid; i < NTOK * 64; i += c.GT) { const int tok = i >> 6, g = i & 63, t = tok & (SEQ - 1);
        u32x4 w = {0u, 0u, 0u, 0u};
        if (g < 60) { const int col = (g < 32) ? (5344 + 8 * g) : (G_OFF + 8 * (g - 32));
            const bf16_t* p0 = proj + (size_t)tok * INP + col; const bf16_t* pp = t > 0 ? p0 - INP : p0; const bf16_t* pn = t < SEQ - 1 ? p0 + INP : p0;
            const float fp = t > 0 ? 1.0f : 0.0f, fn = t < SEQ - 1 ? 1.0f : 0.0f;
            float x0[8], x1[8], x2[8], o[8];
            { const u32x4 w0 = *(const u32x4*)p0, w1 = *(const u32x4*)pp, w2 = *(const u32x4*)pn;
#pragma unroll
              for (int e = 0; e < 4; ++e) { x0[2 * e] = __uint_as_float(w0[e] << 16); x0[2 * e + 1] = __uint_as_float(w0[e] & 0xffff0000u); x1[2 * e] = __uint_as_float(w1[e] << 16); x1[2 * e + 1] = __uint_as_float(w1[e] & 0xffff0000u);
                  x2[2 * e] = __uint_as_float(w2[e] << 16); x2[2 * e + 1] = __uint_as_float(w2[e] & 0xffff0000u); } }
            const f32x4 m0 = *(const f32x4*)(mu + col - 512), m1 = *(const f32x4*)(mu + col - 512 + 4);
#pragma unroll
            for (int e = 0; e < 8; ++e) { const float s = x0[e] + (0.5f * (x1[e] * fp + x2[e] * fn) - x0[e]) * (e < 4 ? m0[e] : m1[e - 4]);
                o[e] = (g < 16) ? (1.0f - 2.0f * __builtin_amdgcn_rcpf(1.0f + __expf(2.0f * s))) : (g < 32) ? s : sigmoidf_(s); }
            w.x = cvt_pk_bf16(o[0], o[1]); w.y = cvt_pk_bf16(o[2], o[3]); w.z = cvt_pk_bf16(o[4], o[5]); w.w = cvt_pk_bf16(o[6], o[7]); }
        ((u32x4*)al)[i] = w; }
}
__device__ __forceinline__ void phase1_fill(const Args& a, LAS unsigned char* lds, int idx, int n) {
    const int lane = threadIdx.x & 63, wave = __builtin_amdgcn_readfirstlane(threadIdx.x >> 6), gtid = idx * 512 + threadIdx.x, GT = n * 512, gw = idx * 8 + wave, NGW = n * 8;
    LAS float* T = (LAS float*)(lds + 131072);
    for (int m = threadIdx.x; m < 2048; m += 512) T[m] = cospif((float)m * (1.0f / 1024.0f)) * 0.022097086912079608f;
    __syncthreads();
    bf16_t* dm = (bf16_t*)(a.ws + WS_DFTM);
    for (int i = gtid; i < 2048 * 4096 / 8; i += GT) { const int sp = i >> 9, k0 = (i & 511) * 8; float v[8];
#pragma unroll
        for (int j = 0; j < 8; ++j) { const int k = k0 + j; v[j] = T[(sp * (k & 2047) + (k < 2048 ? 0 : 512)) & 2047]; }
        u32x4 o; o.x = cvt_pk_bf16(v[0], v[1]); o.y = cvt_pk_bf16(v[2], v[3]); o.z = cvt_pk_bf16(v[4], v[5]); o.w = cvt_pk_bf16(v[6], v[7]); ((u32x4*)dm)[i] = o; }
    __syncthreads();
    bf16_t* wlt = (bf16_t*)(a.ws + WS_WLT);
    for (int i = gtid; i < 6144 * 128; i += GT) { const int n = i >> 7, k = i & 127, q = n / RW, ch = n % RW; float v = 0.f;
        if ((k >> 6) == (q & 1)) { const float* up = (q == 0) ? a.in[3] : (q == 1) ? a.in[4] : (q == 2) ? a.in[7] : a.in[8]; v = up[(size_t)(k & 63) * RW + ch]; }
        wlt[i] = f2bf(v); }
    bf16_t* wgt = (bf16_t*)(a.ws + WS_WLT + 2 * MiB);
    for (int i = gtid; i < 1536 * 256; i += GT) { const int ch = i >> 8, k = i & 255; wgt[i] = f2bf(k < 224 ? a.in[11][(size_t)k * RW + ch] : 0.f); }
    { float* bs = (float*)(a.ws + WS_BIAS);
      for (int i = gtid; i < RW; i += GT) { bs[i] = a.in[5][i]; bs[RW + i] = a.in[6][i]; bs[2 * RW + i] = a.in[9][i]; bs[3 * RW + i] = a.in[10][i]; } }
    bf16_t* cd = (bf16_t*)(a.ws + WS_CDFT);
    for (int i = gtid; i < 1024 * 512; i += GT) { const int m = i >> 9, k = i & 511, part = m >> 9, g = (m >> 7) & 3, cp = m & 127, g2 = k >> 7, cc = k & 127; float v = 0.f;
        if (g == g2) { const float ang = (float)((cc * cp) & 127) * (1.0f / 64.0f); v = (part ? sinpif(ang) : cospif(ang)) * 0.08838834764831845f; }
        cd[i] = f2bf(v); }
    LAS float* scr = (LAS float*)(lds + wave * 16384);
    for (int it = gw; it < 32 * 64; it += NGW) tr_item<0>(a.in[17], DM, DM, (bf16_t*)(a.ws + WS_WOUTT), DM, scr, it, lane);
}

typedef short bf16x4 __attribute__((ext_vector_type(4)));
constexpr int YBUF = 64 * 144;
constexpr int RS = 136, RS2 = 40;
constexpr int SL_AT = 0, SL_RT = 2176, SL_BT = 4352, SL_TT = 4352, SL_KT = 6528, SL_BH = 8704, SL_KH = 11264, SL_V = 13824, SL_WT = 16384, SLOT = 16640;
__device__ __forceinline__ bf16x4 cvt4(const f32x4 v) { u32x2 w; w.x = cvt_pk_bf16(v[0], v[1]); w.y = cvt_pk_bf16(v[2], v[3]); return __builtin_bit_cast(bf16x4, w); }
__device__ __forceinline__ bf16x8 cat8(const bf16x4 lo, const bf16x4 hi) { return __builtin_shufflevector(lo, hi, 0, 1, 2, 3, 4, 5, 6, 7); }
__device__ __forceinline__ f32x4 mfma16(const bf16x4 a, const bf16x4 b, const f32x4 c) { return __builtin_amdgcn_mfma_f32_16x16x16bf16_1k(a, b, c, 0, 0, 0); }
__device__ __forceinline__ f32x4 mfma32(const bf16x8 a, const bf16x8 b, const f32x4 c) { return __builtin_amdgcn_mfma_f32_16x16x32_bf16(a, b, c, 0, 0, 0); }

__device__ __forceinline__ void scan2_phase(const Args& a, LAS unsigned char* lds) {
    const int bid = blockIdx.x; if (bid >= 192) return;
    const int lane = threadIdx.x & 63, wave = __builtin_amdgcn_readfirstlane(threadIdx.x >> 6), dir = wave >> 2, ws = wave & 3;
    const int b = bid / NH, h = bid % NH, ch = h * 64 + lane, fr = lane & 15, g = lane >> 4, i0 = 16 * ws;
    LAS unsigned char* base = lds + dir * (4 * SLOT);
    const float kk_ = a.in[12][ch], ka_ = a.in[13][ch];
    const float mur = a.in[2][R_OFF - 512 + ch], muk = a.in[2][K_OFF - 512 + ch], muv = a.in[2][V_OFF - 512 + ch];
    const unsigned char* P = a.ws + WS_PROJ + (size_t)b * SEQ * INP * 2;
    const unsigned char* LW = a.ws + WS_OUT5 + ((size_t)dir * OUT5_STRIDE + (size_t)b * SEQ * RW) * 2;
    const unsigned char* AI = a.ws + WS_OUT5 + ((size_t)(2 + dir) * OUT5_STRIDE + (size_t)b * SEQ * RW) * 2;
    const unsigned voK = (unsigned)(K_OFF + ch) * 2u, voC = (unsigned)ch * 2u;
    const long sP = dir ? -(long)(INP * 2) : (long)(INP * 2), sL = dir ? -(long)(RW * 2) : (long)(RW * 2);
    bf16_t* Y = (bf16_t*)((unsigned char*)a.out + DO_Y) + (size_t)b * SEQ * RW + h * 64;
    LAS unsigned char* ybuf = lds + 8 * SLOT + dir * YBUF;
    f32x4 St[4];
#pragma unroll
    for (int jt = 0; jt < 4; ++jt) St[jt] = (f32x4){0.f, 0.f, 0.f, 0.f};
    unsigned rru[18], kru[18], vru[18], lwu[16], aiu[16];
#define LDU16(base, boff) ((unsigned)(*(const bf16_t*)((base) + (boff))))
#define SCAN_LOAD_RAW(cidx) do { \
        const int t0_ = dir ? (SEQ - 16 * (cidx)) : (16 * (cidx) - 1), l0_ = dir ? (SEQ - 1 - 16 * (cidx)) : (16 * (cidx)); \
        const unsigned char* bP_ = P + (long)t0_ * (INP * 2); const unsigned char* bL_ = LW + (long)l0_ * (RW * 2); const unsigned char* bA_ = AI + (long)l0_ * (RW * 2); \
        _Pragma("unroll") for (int i = 0; i < 18; ++i) { const unsigned char* rb = bP_ + sP * i; \
            rru[i] = LDU16(rb, voK - (K_OFF - R_OFF) * 2); kru[i] = LDU16(rb, voK); vru[i] = LDU16(rb, voK + (V_OFF - K_OFF) * 2); } \
        _Pragma("unroll") for (int i = 0; i < 16; ++i) { lwu[i] = LDU16(bL_ + sL * i, voC); aiu[i] = LDU16(bA_ + sL * i, voC); } } while (0)
    SCAN_LOAD_RAW(ws);
    constexpr int NG = SEQ / 64;
#define SCAN_WRITE_OUT(Gw) do { _Pragma("unroll") for (int q = 0; q < 2; ++q) { const int tl = 16 * ws + (lane >> 3) + 8 * q, tau = 64 * (Gw) + tl, t = dir ? (SEQ - 1 - tau) : tau; \
            u32x4* yp = (u32x4*)(Y + (size_t)t * RW + (lane & 7) * 8); \
            u32x4 w = *(const LAS u32x4*)(ybuf + tl * 144 + (lane & 7) * 16); \
            if ((Gw) >= NG / 2) { const u32x4 o = *yp; \
                _Pragma("unroll") for (int e = 0; e < 4; ++e) w[e] = cvt_pk_bf16(__uint_as_float(w[e] << 16) + __uint_as_float(o[e] << 16), __uint_as_float(w[e] & 0xffff0000u) + __uint_as_float(o[e] & 0xffff0000u)); } \
            *yp = w; } } while (0)
    for (int I = 0; I < 2 * NG + 1; ++I) {
        const int ph = I - dir;
        if (ph >= 0 && ph < 2 * NG) {
        const int G = ph >> 1;
        LAS unsigned char* slot = base + ws * SLOT;
        if ((ph & 1) == 0) {
        if (G > 0) SCAN_WRITE_OUT(G - 1);
        {
            float rr[18], kr[18], vr[18], lwv[16], aiv[16];
            { const int cidx = 4 * G + ws;
#pragma unroll
              for (int i = 0; i < 18; ++i) { const unsigned m = (i == 0) ? ((cidx == 0) ? 0u : 0xffffffffu) : (i == 17) ? ((cidx == SEQ / 16 - 1) ? 0u : 0xffffffffu) : 0xffffffffu;
                  rr[i] = __uint_as_float((rru[i] << 16) & m); kr[i] = __uint_as_float((kru[i] << 16) & m); vr[i] = __uint_as_float((vru[i] << 16) & m); }
#pragma unroll
              for (int i = 0; i < 16; ++i) { lwv[i] = __uint_as_float(lwu[i] << 16); aiv[i] = __uint_as_float(aiu[i] << 16); } }
            float E[17], Ei[16]; E[0] = 1.0f;
            { float Lc = 0.f;
#pragma unroll
              for (int tt = 0; tt < 16; ++tt) { Lc += lwv[tt] * 1.4426950408889634f; E[tt + 1] = __builtin_amdgcn_exp2f(Lc); Ei[tt] = __builtin_amdgcn_exp2f(-Lc); } }
            const float ET = E[16];
            float bh[16], kh[16], vv[16];
#pragma unroll
            for (int tp = 0; tp < 16; tp += 2) {
                float av[2], bv[2], kv[2], rv[2];
#pragma unroll
                for (int u = 0; u < 2; ++u) { const int tt = tp + u;
                    const float r = rr[tt + 1] + (0.5f * (rr[tt] + rr[tt + 2]) - rr[tt + 1]) * mur;
                    const float k = kr[tt + 1] + (0.5f * (kr[tt] + kr[tt + 2]) - kr[tt + 1]) * muk;
                    const float v = vr[tt + 1] + (0.5f * (vr[tt] + vr[tt + 2]) - vr[tt + 1]) * muv;
                    const float ai = aiv[tt];
                    const float kkr = k * kk_; const float n2 = wave_sum_dpp(kkr * kkr);
                    const float kk = kkr * rsqrtf(fmaxf(n2, 1e-24f));
                    const float kd = k * (1.0f + (ai - 1.0f) * ka_);
                    const float bt = kk * ai * Ei[tt], kt = kd * Ei[tt];
                    av[u] = -kk * E[tt]; bv[u] = bt; kv[u] = kt; rv[u] = r * E[tt + 1];
                    bh[tt] = bt * ET; kh[tt] = kt * ET; vv[tt] = v; }
                const unsigned wa = cvt_pk_bf16(av[0], av[1]), wb = cvt_pk_bf16(bv[0], bv[1]), wk = cvt_pk_bf16(kv[0], kv[1]), wr_ = cvt_pk_bf16(rv[0], rv[1]);
                *(LAS bf16_t*)(slot + SL_AT + tp * RS + lane * 2) = (bf16_t)(wa & 0xffffu); *(LAS bf16_t*)(slot + SL_AT + (tp + 1) * RS + lane * 2) = (bf16_t)(wa >> 16);
                *(LAS bf16_t*)(slot + SL_BT + tp * RS + lane * 2) = (bf16_t)(wb & 0xffffu); *(LAS bf16_t*)(slot + SL_BT + (tp + 1) * RS + lane * 2) = (bf16_t)(wb >> 16);
                *(LAS bf16_t*)(slot + SL_KT + tp * RS + lane * 2) = (bf16_t)(wk & 0xffffu); *(LAS bf16_t*)(slot + SL_KT + (tp + 1) * RS + lane * 2) = (bf16_t)(wk >> 16);
                *(LAS bf16_t*)(slot + SL_RT + tp * RS + lane * 2) = (bf16_t)(wr_ & 0xffffu); *(LAS bf16_t*)(slot + SL_RT + (tp + 1) * RS + lane * 2) = (bf16_t)(wr_ >> 16);
            }
#pragma unroll
            for (int q = 0; q < 4; ++q) { u32x2 w0, w1, w2;
                w0.x = cvt_pk_bf16(bh[4 * q + 0], bh[4 * q + 1]); w0.y = cvt_pk_bf16(bh[4 * q + 2], bh[4 * q + 3]);
                w1.x = cvt_pk_bf16(kh[4 * q + 0], kh[4 * q + 1]); w1.y = cvt_pk_bf16(kh[4 * q + 2], kh[4 * q + 3]);
                w2.x = cvt_pk_bf16(vv[4 * q + 0], vv[4 * q + 1]); w2.y = cvt_pk_bf16(vv[4 * q + 2], vv[4 * q + 3]);
                *(LAS u32x2*)(slot + SL_BH + lane * RS2 + q * 8) = w0; *(LAS u32x2*)(slot + SL_KH + lane * RS2 + q * 8) = w1; *(LAS u32x2*)(slot + SL_V + lane * RS2 + q * 8) = w2; }
            *(LAS float*)(slot + SL_WT + lane * 4) = ET;
        }
        if (G + 1 < SEQ / 64) SCAN_LOAD_RAW(4 * (G + 1) + ws);
        LDS_WAIT(); __builtin_amdgcn_wave_barrier();
        {
            bf16x8 fa[2], fb[2], fk[2], frr[2];
#pragma unroll
            for (int m = 0; m < 2; ++m) { const int off = fr * RS + (32 * m + 8 * g) * 2;
                fa[m] = cat8(*(const LAS bf16x4*)(slot + SL_AT + off), *(const LAS bf16x4*)(slot + SL_AT + off + 8)); fb[m] = cat8(*(const LAS bf16x4*)(slot + SL_BT + off), *(const LAS bf16x4*)(slot + SL_BT + off + 8));
                fk[m] = cat8(*(const LAS bf16x4*)(slot + SL_KT + off), *(const LAS bf16x4*)(slot + SL_KT + off + 8)); frr[m] = cat8(*(const LAS bf16x4*)(slot + SL_RT + off), *(const LAS bf16x4*)(slot + SL_RT + off + 8)); }
            const f32x4 z4 = {0.f, 0.f, 0.f, 0.f};
            f32x4 aP = mfma32(fa[1], fb[1], mfma32(fa[0], fb[0], z4));
            f32x4 aPT = mfma32(fb[1], fa[1], mfma32(fb[0], fa[0], z4));
            f32x4 aKa = mfma32(fk[1], fa[1], mfma32(fk[0], fa[0], z4));
            f32x4 aBr = mfma32(fb[1], frr[1], mfma32(fb[0], frr[0], z4));
            f32x4 aKr = mfma32(fk[1], frr[1], mfma32(fk[0], frr[0], z4));
            f32x4 aU;
#pragma unroll
            for (int jj = 0; jj < 4; ++jj) { const int rw = 4 * g + jj;
                aP[jj] = (fr < rw) ? aP[jj] : 0.f; aPT[jj] = (rw < fr) ? aPT[jj] : 0.f; aKa[jj] = (rw < fr) ? aKa[jj] : 0.f;
                aBr[jj] = (rw <= fr) ? aBr[jj] : 0.f; aKr[jj] = (rw <= fr) ? aKr[jj] : 0.f; aU[jj] = aPT[jj] + ((rw == fr) ? 1.0f : 0.f); }
            const bf16x4 pP = cvt4(aP), pPT = cvt4(aPT);
            const f32x4 aP2 = mfma16(pPT, pP, z4), aPT2 = mfma16(pP, pPT, z4);
            const bf16x4 pP2 = cvt4(aP2), pPT2 = cvt4(aPT2);
            aU = mfma16(pP2, cvt4(aU), aU);
            const f32x4 aP4 = mfma16(pPT2, pP2, z4), aPT4 = mfma16(pP2, pPT2, z4);
            const bf16x4 pP4 = cvt4(aP4), pPT4 = cvt4(aPT4);
            aU = mfma16(pP4, cvt4(aU), aU);
            const f32x4 aP8 = mfma16(pPT4, pP4, z4);
            aU = mfma16(cvt4(aP8), cvt4(aU), aU);
            *(LAS bf16x4*)(slot + SL_TT + 0 * 512 + lane * 8) = cvt4(aU);
            *(LAS bf16x4*)(slot + SL_TT + 1 * 512 + lane * 8) = cvt4(aKa);
            *(LAS bf16x4*)(slot + SL_TT + 2 * 512 + lane * 8) = cvt4(aBr);
            *(LAS bf16x4*)(slot + SL_TT + 3 * 512 + lane * 8) = cvt4(aKr);
        }
        } else {
        for (int cc = 0; cc < 4; ++cc) {
            const LAS unsigned char* sl = base + cc * SLOT;
            bf16x8 Af[2], Rf[2], BK[4]; f32x4 wt[4];
#pragma unroll
            for (int m = 0; m < 2; ++m) { const int off = fr * RS + (32 * m + 4 * g) * 2;
                Af[m] = cat8(*(const LAS bf16x4*)(sl + SL_AT + off), *(const LAS bf16x4*)(sl + SL_AT + off + 32));
                Rf[m] = cat8(*(const LAS bf16x4*)(sl + SL_RT + off), *(const LAS bf16x4*)(sl + SL_RT + off + 32)); }
#pragma unroll
            for (int jt = 0; jt < 4; ++jt) { const int off = (16 * jt + fr) * RS2 + 8 * g;
                BK[jt] = cat8(*(const LAS bf16x4*)(sl + SL_BH + off), *(const LAS bf16x4*)(sl + SL_KH + off));
                wt[jt] = *(const LAS f32x4*)(sl + SL_WT + (16 * jt + 4 * g) * 4); }
            const bf16x4 tU = *(const LAS bf16x4*)(sl + SL_TT + 0 * 512 + lane * 8), tKa = *(const LAS bf16x4*)(sl + SL_TT + 1 * 512 + lane * 8);
            const bf16x4 tBr = *(const LAS bf16x4*)(sl + SL_TT + 2 * 512 + lane * 8), tKr = *(const LAS bf16x4*)(sl + SL_TT + 3 * 512 + lane * 8);
            const bf16x4 Vf = *(const LAS bf16x4*)(sl + SL_V + (i0 + fr) * RS2 + 8 * g);
            const bf16x8 B01 = cat8(cvt4(St[0]), cvt4(St[1])), B23 = cat8(cvt4(St[2]), cvt4(St[3]));
            const f32x4 z4 = {0.f, 0.f, 0.f, 0.f};
            f32x4 X = mfma32(Af[0], B01, z4); X = mfma32(Af[1], B23, X); X = mfma16(tKa, Vf, X);
            const f32x4 SA = mfma16(tU, cvt4(X), z4);
            const bf16x8 BSV = cat8(cvt4(SA), Vf);
            f32x4 Yv = mfma32(Rf[0], B01, z4); Yv = mfma32(Rf[1], B23, Yv); Yv = mfma32(cat8(tBr, tKr), BSV, Yv);
#pragma unroll
            for (int jt = 0; jt < 4; ++jt) St[jt] = mfma32(BK[jt], BSV, St[jt] * wt[jt]);
#pragma unroll
            for (int jj = 0; jj < 4; ++jj) *(LAS bf16_t*)(ybuf + (16 * cc + 4 * g + jj) * 144 + (i0 + fr) * 2) = f2bf(Yv[jj]);
        }
        } }
        if (I == NG || I == NG + 1) asm volatile("s_waitcnt vmcnt(0)" ::: "memory");
        RAW_BARRIER();
    }
    SCAN_WRITE_OUT(NG - 1);
    RAW_BARRIER();
#undef SCAN_WRITE_OUT
#undef SCAN_LOAD_RAW
#undef LDU16
}

__device__ __forceinline__ void unpack8(const u32x4 w, float (&f)[8]) {
#pragma unroll
    for (int i = 0; i < 4; ++i) { f[2 * i] = __uint_as_float(w[i] << 16); f[2 * i + 1] = __uint_as_float(w[i] & 0xffff0000u); }
}
__device__ __forceinline__ float sum8lanes(float v) {
    v += __builtin_bit_cast(float, __builtin_amdgcn_update_dpp(0, __builtin_bit_cast(int, v), 0xB1, 0xf, 0xf, true));
    v += __builtin_bit_cast(float, __builtin_amdgcn_update_dpp(0, __builtin_bit_cast(int, v), 0x4E, 0xf, 0xf, true));
    v += __builtin_bit_cast(float, __builtin_amdgcn_update_dpp(0, __builtin_bit_cast(int, v), 0x141, 0xf, 0xf, true));
    return v; }
__device__ __forceinline__ void post_phase(const Ctx& c) {
    if (c.gw >= 2046) return;
    const int third = c.gw % 3, cb = third * 512 + c.lane * 8;
    const bf16_t* proj = (const bf16_t*)(c.a.ws + WS_PROJ);
    const bf16_t* o5 = (const bf16_t*)(c.a.ws + WS_OUT5);
    const bf16_t* yy = (const bf16_t*)((unsigned char*)c.a.out + DO_Y);
    bf16_t* amix = (bf16_t*)(c.a.ws + WS_AMIX);
    float mur[8], muk[8], muv[8], lg[8], lb[8], ka[8], rk[8];
#pragma unroll
    for (int e = 0; e < 8; ++e) { mur[e] = c.a.in[2][R_OFF - 512 + cb + e]; muk[e] = c.a.in[2][K_OFF - 512 + cb + e]; muv[e] = c.a.in[2][V_OFF - 512 + cb + e];
        lg[e] = c.a.in[15][cb + e]; lb[e] = c.a.in[16][cb + e]; ka[e] = c.a.in[13][cb + e]; rk[e] = c.a.in[14][cb + e]; }
    for (int tok = c.gw / 3; tok < NTOK; tok += 682) {
        const int t = tok & (SEQ - 1);
        const float fp = t > 0 ? 1.0f : 0.0f, fn = t < SEQ - 1 ? 1.0f : 0.0f;
        const bf16_t* p0 = proj + (size_t)tok * INP + cb; const bf16_t* pp = t > 0 ? p0 - INP : p0; const bf16_t* pn = t < SEQ - 1 ? p0 + INP : p0;
        const u32x4 wr0 = *(const u32x4*)(p0 + R_OFF), wrp = *(const u32x4*)(pp + R_OFF), wrn = *(const u32x4*)(pn + R_OFF);
        const u32x4 wk0 = *(const u32x4*)(p0 + K_OFF), wkp = *(const u32x4*)(pp + K_OFF), wkn = *(const u32x4*)(pn + K_OFF);
        const u32x4 wv0 = *(const u32x4*)(p0 + V_OFF), wvp = *(const u32x4*)(pp + V_OFF), wvn = *(const u32x4*)(pn + V_OFF);
        const size_t e0 = (size_t)tok * RW + cb;
        const u32x4 wyy = *(const u32x4*)(yy + e0), waf = *(const u32x4*)(o5 + 2 * OUT5_STRIDE + e0), wab = *(const u32x4*)(o5 + 3 * OUT5_STRIDE + e0), wg = *(const u32x4*)(o5 + 4 * OUT5_STRIDE + e0);
        float r[8], k[8], v[8], y[8], x0[8], x1[8], x2[8];
        unpack8(wr0, x0); unpack8(wrp, x1); unpack8(wrn, x2);
#pragma unroll
        for (int e = 0; e < 8; ++e) r[e] = x0[e] + (0.5f * (x1[e] * fp + x2[e] * fn) - x0[e]) * mur[e];
        unpack8(wk0, x0); unpack8(wkp, x1); unpack8(wkn, x2);
#pragma unroll
        for (int e = 0; e < 8; ++e) k[e] = x0[e] + (0.5f * (x1[e] * fp + x2[e] * fn) - x0[e]) * muk[e];
        unpack8(wv0, x0); unpack8(wvp, x1); unpack8(wvn, x2);
#pragma unroll
        for (int e = 0; e < 8; ++e) v[e] = x0[e] + (0.5f * (x1[e] * fp + x2[e] * fn) - x0[e]) * muv[e];
        unpack8(wyy, y);
        float s = 0.f;
#pragma unroll
        for (int e = 0; e < 8; ++e) s += y[e];
        const float m = sum8lanes(s) * (1.0f / 64.0f);
        float s2 = 0.f;
#pragma unroll
        for (int e = 0; e < 8; ++e) { y[e] -= m; s2 += y[e] * y[e]; }
        const float rstd = rsqrtf(sum8lanes(s2) * (1.0f / 64.0f) + GN_EPS);
        unpack8(waf, x0); unpack8(wab, x1); unpack8(wg, x2);
        float bs = 0.f;
#pragma unroll
        for (int e = 0; e < 8; ++e) bs += r[e] * k[e] * (2.0f + (x0[e] + x1[e] - 2.0f) * ka[e]) * rk[e];
        const float bon = sum8lanes(bs);
        float o[8];
#pragma unroll
        for (int e = 0; e < 8; ++e) o[e] = (y[e] * rstd * lg[e] + lb[e] + bon * v[e]) * x2[e];
        u32x4 w; w.x = cvt_pk_bf16(o[0], o[1]); w.y = cvt_pk_bf16(o[2], o[3]); w.z = cvt_pk_bf16(o[4], o[5]); w.w = cvt_pk_bf16(o[6], o[7]);
        *(u32x4*)(amix + (size_t)tok * DM + 512 + cb) = w;
    }
}

__device__ __forceinline__ void ln_phase(const Ctx& c, float* Z, bf16_t* ZB, const float* g, const float* bta, float* O) {
    for (int row0 = c.gw; row0 < NTOK; row0 += 2 * c.NGW) {
        f32x4 v[2][8]; float s[2] = {0.f, 0.f};
#pragma unroll
        for (int u = 0; u < 2; ++u) { const f32x4* zr = (const f32x4*)(Z + (size_t)(row0 + u * c.NGW) * DM) + c.lane;
#pragma unroll
            for (int j = 0; j < 8; ++j) v[u][j] = zr[64 * j]; }
#pragma unroll
        for (int u = 0; u < 2; ++u)
#pragma unroll
            for (int j = 0; j < 8; ++j) s[u] += (v[u][j][0] + v[u][j][1]) + (v[u][j][2] + v[u][j][3]);
        float mean[2], s2[2] = {0.f, 0.f}, rstd[2];
#pragma unroll
        for (int u = 0; u < 2; ++u) mean[u] = wave_sum(s[u]) * (1.0f / DM);
#pragma unroll
        for (int u = 0; u < 2; ++u)
#pragma unroll
            for (int j = 0; j < 8; ++j) { v[u][j] = v[u][j] - mean[u]; s2[u] += (v[u][j][0] * v[u][j][0] + v[u][j][1] * v[u][j][1]) + (v[u][j][2] * v[u][j][2] + v[u][j][3] * v[u][j][3]); }
#pragma unroll
        for (int u = 0; u < 2; ++u) rstd[u] = rsqrtf(wave_sum(s2[u]) * (1.0f / DM) + LN_EPS);
#pragma unroll
        for (int j = 0; j < 8; ++j) { const f32x4 gg = ((const f32x4*)g)[c.lane + 64 * j], bb = ((const f32x4*)bta)[c.lane + 64 * j];
#pragma unroll
            for (int u = 0; u < 2; ++u) { const size_t row = (size_t)(row0 + u * c.NGW);
                const f32x4 o = v[u][j] * rstd[u] * gg + bb;
                if (O) ((f32x4*)(O + row * DM))[c.lane + 64 * j] = o;
                if (ZB) { u32x2 w; w.x = cvt_pk_bf16(o[0], o[1]); w.y = cvt_pk_bf16(o[2], o[3]); ((u32x2*)(ZB + row * DM))[c.lane + 64 * j] = w; } } }
    }
}


#define XB_TMO      128
#define XB_XCNT(j)  (256  + 64 * (j))
#define XB_XSUB(j)  (1280 + 64 * (j))
#define XB_XGEN(j)  (2304 + 64 * (j))
#define XB_TOP      3328
#define XB_TOPGEN   3392
#define XCD_BAR_WORDS 3456
#define XB_SPIN_CAP (1u << 18)
__device__ __forceinline__ unsigned xb_ld(unsigned* p)              { return __hip_atomic_load(p, __ATOMIC_RELAXED, __HIP_MEMORY_SCOPE_AGENT); }
__device__ __forceinline__ unsigned xb_add(unsigned* p, unsigned v) { return __hip_atomic_fetch_add(p, v, __ATOMIC_RELAXED, __HIP_MEMORY_SCOPE_AGENT); }
__device__ __forceinline__ unsigned xb_xcc_id() { return (unsigned)__builtin_amdgcn_s_getreg((3 << 11) | 20) & 0xFu; }
#define XB_SPIN(cond, bar) do { unsigned _sp = 0; while (cond) { __builtin_amdgcn_s_sleep(1); \
    if ((++_sp & 255u) == 0u) { if (xb_ld(&(bar)[XB_TMO])) break; if (_sp > XB_SPIN_CAP) { atomicAdd(&(bar)[XB_TMO], 1u); break; } } } } while (0)
struct XcdBarrier { unsigned* bar; unsigned x; volatile LAS unsigned* st; };
__device__ __forceinline__ XcdBarrier xcd_barrier_post(unsigned* bar, volatile LAS unsigned* st) {
    XcdBarrier b; b.bar = bar; b.x = xb_xcc_id(); b.st = st;
    if (threadIdx.x == 0) (void)xb_add(&bar[XB_XCNT(b.x)], 1u);
    return b;
}
__device__ __forceinline__ void xcd_barrier_complete(unsigned* bar, unsigned x, unsigned& nloc, unsigned& nx) {
    const unsigned G = gridDim.x * gridDim.y * gridDim.z;
    unsigned sum, cnt, mine, sp = 0u;
    for (;;) {
        sum = 0u; cnt = 0u; mine = 0u;
#pragma unroll
        for (unsigned j = 0; j < 16; ++j) { const unsigned c = xb_ld(&bar[XB_XCNT(j)]); sum += c; cnt += (c > 0u) ? 1u : 0u; mine = (j == x) ? c : mine; }
        if (sum == G) break;
        __builtin_amdgcn_s_sleep(1);
        if ((++sp & 255u) == 0u) { if (xb_ld(&bar[XB_TMO])) break; if (sp > XB_SPIN_CAP) { atomicAdd(&bar[XB_TMO], 1u); break; } }
    }
    nloc = mine > 0u ? mine : 1u; nx = cnt > 0u ? cnt : 1u;
}
__device__ __forceinline__ void xcd_barrier(const XcdBarrier& b) {
    asm volatile("s_waitcnt vmcnt(0)" ::: "memory");
    __syncthreads();
    if (threadIdx.x == 0) {
        unsigned* bar = b.bar;
        __builtin_amdgcn_s_waitcnt(0);
        unsigned nloc = b.st[0], nx = b.st[1];
        if (nloc == 0u) { xcd_barrier_complete(bar, b.x, nloc, nx); b.st[0] = nloc; b.st[1] = nx; }
        const unsigned old = xb_add(&bar[XB_XSUB(b.x)], 1u);
        const unsigned gen = old / nloc;
        if (old + 1u == (gen + 1u) * nloc) {
            __builtin_amdgcn_fence(__ATOMIC_RELEASE, "agent");
            asm volatile("s_waitcnt vmcnt(0)" ::: "memory");
            const unsigned og = xb_add(&bar[XB_TOP], 1u);
            const unsigned tg = og / nx;
            if (og + 1u == (tg + 1u) * nx) xb_add(&bar[XB_TOPGEN], 1u);
            else XB_SPIN(xb_ld(&bar[XB_TOPGEN]) == tg, bar);
            __builtin_amdgcn_fence(__ATOMIC_ACQUIRE, "agent");
            xb_add(&bar[XB_XGEN(b.x)], 1u);
            asm volatile("s_waitcnt vmcnt(0)" ::: "memory");
        } else {
            XB_SPIN(xb_ld(&bar[XB_XGEN(b.x)]) == gen, bar);
            __builtin_amdgcn_fence(__ATOMIC_ACQUIRE, "agent");
            asm volatile("s_waitcnt vmcnt(0)" ::: "memory");
        }
    }
    __syncthreads();
}

template <bool OUT_F32> __device__ __forceinline__ void ln_bf16_phase(const Ctx& c, const bf16_t* Z, void* Ov, const float* g, const float* bta) {
    for (int row0 = c.gw; row0 < NTOK; row0 += 2 * c.NGW) {
        float v[2][32]; float s[2] = {0.f, 0.f};
#pragma unroll
        for (int u = 0; u < 2; ++u) { const u32x4* zr = (const u32x4*)(Z + (size_t)(row0 + u * c.NGW) * DM) + c.lane;
#pragma unroll
            for (int j = 0; j < 4; ++j) { const u32x4 w = zr[64 * j];
#pragma unroll
                for (int e = 0; e < 4; ++e) { v[u][8 * j + 2 * e] = __uint_as_float(w[e] << 16); v[u][8 * j + 2 * e + 1] = __uint_as_float(w[e] & 0xffff0000u); } } }
#pragma unroll
        for (int u = 0; u < 2; ++u)
#pragma unroll
            for (int e = 0; e < 32; ++e) s[u] += v[u][e];
        float mean[2], s2[2] = {0.f, 0.f}, rstd[2];
#pragma unroll
        for (int u = 0; u < 2; ++u) mean[u] = wave_sum_dpp(s[u]) * (1.0f / DM);
#pragma unroll
        for (int u = 0; u < 2; ++u)
#pragma unroll
            for (int e = 0; e < 32; ++e) { v[u][e] -= mean[u]; s2[u] += v[u][e] * v[u][e]; }
#pragma unroll
        for (int u = 0; u < 2; ++u) rstd[u] = rsqrtf(wave_sum_dpp(s2[u]) * (1.0f / DM) + LN_EPS);
#pragma unroll
        for (int j = 0; j < 4; ++j) { const f32x4 g0 = ((const f32x4*)g)[2 * (c.lane + 64 * j)], g1 = ((const f32x4*)g)[2 * (c.lane + 64 * j) + 1];
            const f32x4 b0 = ((const f32x4*)bta)[2 * (c.lane + 64 * j)], b1 = ((const f32x4*)bta)[2 * (c.lane + 64 * j) + 1];
#pragma unroll
            for (int u = 0; u < 2; ++u) { float o[8];
#pragma unroll
                for (int e = 0; e < 4; ++e) { o[e] = v[u][8 * j + e] * rstd[u] * g0[e] + b0[e]; o[4 + e] = v[u][8 * j + 4 + e] * rstd[u] * g1[e] + b1[e]; }
                if (OUT_F32) { f32x4* op = (f32x4*)((float*)Ov + (size_t)(row0 + u * c.NGW) * DM) + 2 * (c.lane + 64 * j);
                    op[0] = (f32x4){o[0], o[1], o[2], o[3]}; op[1] = (f32x4){o[4], o[5], o[6], o[7]}; }
                else { u32x4 w; w.x = cvt_pk_bf16(o[0], o[1]); w.y = cvt_pk_bf16(o[2], o[3]); w.z = cvt_pk_bf16(o[4], o[5]); w.w = cvt_pk_bf16(o[6], o[7]);
                    ((u32x4*)((bf16_t*)Ov + (size_t)(row0 + u * c.NGW) * DM))[c.lane + 64 * j] = w; } } }
    }
}

constexpr int N_PHASES = 11;
constexpr int LDS_BYTES = 8 * SLOT + 2 * YBUF;

#ifndef PROBE_REP_PHASE
#define PROBE_REP_PHASE -1
#endif
#define PHASE(n) if (a.ph_lo <= (n) && (n) < a.ph_hi) for (int rep_ = 0; rep_ < ((n) == PROBE_REP_PHASE ? 2 : 1); ++rep_)
#define SEAM(n) do { if (a.ph_lo < (n) && (n) < a.ph_hi) xcd_barrier(xb); __syncthreads(); } while (0)
__global__ void __launch_bounds__(512, 2) fwd_megakernel(Args a) {
    extern __shared__ __attribute__((aligned(16))) unsigned char smem[];
    LAS unsigned char* lds = (LAS unsigned char*)smem;
    const int G = gridDim.x, bid = blockIdx.x;
    __shared__ uint4 xb_words;
    if (threadIdx.x == 0) xb_words = make_uint4(0u, 0u, 0u, 0u);
    __syncthreads();
    XcdBarrier xb; xb.bar = (unsigned*)(a.ws + WS_BAR); xb.x = 0; xb.st = (volatile LAS unsigned*)&xb_words;
    if (a.ph_hi - a.ph_lo > 1) xb = xcd_barrier_post((unsigned*)(a.ws + WS_BAR), (volatile LAS unsigned*)&xb_words);
    if (a.ph_hi > 1000) cg::this_grid().sync();
    PHASE(0) { Ctx c(a, lds); phase0(c); }
    SEAM(1);
    PHASE(1) {
        pg8::Order<0> S; S.init(NTOK, INP, G, bid, a.ws + WS_XB, DM, a.ws + WS_WINT, DM);
        pg8::EpiBf16 E{(bf16_t*)(a.ws + WS_PROJ), INP};
        pg8::gemm_phase(lds, DM, DM, DM, S, E);
        __syncthreads();
        if (G == 256 && bid >= 128) phase1_fill(a, lds, bid - 128, 128);
        else if (G != 256) phase1_fill(a, lds, bid, G); }
    SEAM(2);
    PHASE(2) { Ctx c(a, lds); phase2(c); }
    SEAM(3);
    PHASE(3) {
        pg8::Order<3> S; S.init(NTOK, 6144, G, bid, (unsigned char*)a.out + DO_ALORA, 512, a.ws + WS_WLT, 128);
        pg8::EpiLora E{(bf16_t*)(a.ws + WS_OUT5), (const float*)(a.ws + WS_BIAS), 0};
        pg8::gemm_phase(lds, 128, 512, 128, S, E); }
    __syncthreads();
    PHASE(3) {
        pg8::Order<0> S; S.init(NTOK, 1536, G, bid, (unsigned char*)a.out + DO_ALORA + 512, 512, a.ws + WS_WLT + 2 * MiB, 256);
        pg8::EpiLora E{(bf16_t*)(a.ws + WS_OUT5), (const float*)(a.ws + WS_BIAS), 4};
        pg8::gemm_phase(lds, 256, 512, 256, S, E); }
    __syncthreads();
    PHASE(3) {
        pg8::Order<0> S; S.init(1024, NTOK, G, bid, a.ws + WS_CDFT, 512, a.ws + WS_PROJ, INP);
        pg8::EpiCdft E{(bf16_t*)((unsigned char*)a.out + DO_FABT)};
        pg8::gemm_phase(lds, 512, 512, INP, S, E); }
    SEAM(4);
    PHASE(4) {
        if (bid >= 192) {
            pg8::Order<2> S; S.init(NTOK, 512, 64, bid - 192, a.ws + WS_DFTM, 4096, (unsigned char*)a.out + DO_FABT, 4096);
            pg8::EpiBf16 E{(bf16_t*)(a.ws + WS_AMIX), DM};
            pg8::gemm_phase(lds, 4096, 4096, 4096, S, E);
            __syncthreads();
            {
                const int lane = threadIdx.x & 63, wave = __builtin_amdgcn_readfirstlane(threadIdx.x >> 6);
                LAS float* scr = (LAS float*)(lds + wave * 16384);
                for (int it = (bid - 192) * 8 + wave; it < 88 * 64; it += 64 * 8) tr_item<0>(a.in[22], DFF, DM, (bf16_t*)((unsigned char*)a.out + DO_WDNT), DFF, scr, it, lane); }
        } else scan2_phase(a, lds); }
    SEAM(5);
    PHASE(5) { Ctx c(a, lds); post_phase(c); }
    SEAM(6);
    PHASE(6) {
        pg8::Order<0> S; S.init(NTOK, DM, G, bid, a.ws + WS_AMIX, DM, a.ws + WS_WOUTT, DM);
        pg8::EpiResToBf16 E{(bf16_t*)(a.ws + WS_H), a.in[0]};
        pg8::gemm_phase(lds, DM, DM, DM, S, E); }
    SEAM(7);
    PHASE(7) {
        Ctx c(a, lds);
        ln_bf16_phase<false>(c, (const bf16_t*)(a.ws + WS_H), a.ws + WS_HB, a.in[18], a.in[19]);
        LAS float* scr = (LAS float*)(lds + c.wave * 16384);
        for (int it = c.gw; it < 32 * 176; it += c.NGW) tr_item<1>(a.in[20], DM, DFF, (bf16_t*)(a.ws + WS_WGUT), DM, scr, it, c.lane);
        for (int it = c.gw; it < 32 * 176; it += c.NGW) tr_item<2>(a.in[21], DM, DFF, (bf16_t*)(a.ws + WS_WGUT), DM, scr, it, c.lane);
    }
    SEAM(8);
    PHASE(8) {
        pg8::Order<0> S; S.init(NTOK, 2 * DFF, G, bid, a.ws + WS_HB, DM, a.ws + WS_WGUT, DM);
        pg8::EpiSwiglu E{(bf16_t*)(a.ws + WS_FFA)};
        pg8::gemm_phase(lds, DM, DM, DM, S, E); }
    SEAM(9);
    PHASE(9) {
        pg8::Order<0> S; S.init(NTOK, DM, G, bid, a.ws + WS_FFA, DFF, (unsigned char*)a.out + DO_WDNT, DFF);
        pg8::EpiResBfToBf E{(bf16_t*)(a.ws + WS_H), (const bf16_t*)(a.ws + WS_HB)};
        pg8::gemm_phase(lds, DFF, DFF, DFF, S, E); }
    SEAM(10);
    PHASE(10) { Ctx c(a, lds); ln_bf16_phase<true>(c, (const bf16_t*)(a.ws + WS_H), a.out, a.in[23], a.in[24]); }
}

extern "C" void kernel_launch(void* const* d_in, const int* in_sizes, int n_in, void* d_out, int out_size, void* d_ws, size_t ws_size, hipStream_t stream) {
    static int grid = 0;
    if (grid == 0) {
        if (n_in != 25 || out_size != NTOK * DM || ws_size < WS_END) { fprintf(stderr, "kernel_launch: unexpected shapes (n_in %d out %d ws %zu need %zu)\n", n_in, out_size, ws_size, (size_t)WS_END); grid = -1; return; }
        int dev = 0, cus = 0, per_cu = 0;
        hipGetDevice(&dev); hipDeviceGetAttribute(&cus, hipDeviceAttributeMultiprocessorCount, dev);
        if (hipFuncSetAttribute((const void*)fwd_megakernel, hipFuncAttributeMaxDynamicSharedMemorySize, LDS_BYTES) != hipSuccess) { fprintf(stderr, "kernel_launch: hipFuncSetAttribute failed\n"); grid = -1; return; }
        hipOccupancyMaxActiveBlocksPerMultiprocessor(&per_cu, (const void*)fwd_megakernel, 512, LDS_BYTES);
        if (per_cu < 1) { fprintf(stderr, "kernel_launch: occupancy query says %d blocks per CU\n", per_cu); (void)hipGetLastError(); per_cu = 1; }
        grid = cus < 256 ? cus : 256;
    }
    if (grid < 0) return;
    Args a{};
    for (int i = 0; i < 25; ++i) a.in[i] = (const float*)d_in[i];
    a.out = (float*)d_out; a.ws = (unsigned char*)d_ws;
#if N_LAUNCH_MODE == 1
    if (hipMemsetAsync((unsigned char*)d_ws + WS_BAR, 0, XCD_BAR_WORDS * 4, stream) != hipSuccess) { fprintf(stderr, "kernel_launch: memset of the barrier words failed\n"); return; }
    a.ph_lo = 0; a.ph_hi = N_PHASES;
    void* args[] = {&a};
    hipError_t e = hipLaunchCooperativeKernel((const void*)fwd_megakernel, dim3(grid), dim3(512), args, LDS_BYTES, stream);
    if (e != hipSuccess) fprintf(stderr, "cooperative launch failed: %s (grid %d)\n", hipGetErrorString(e), grid);
#else
    for (int ph = 0; ph < N_PHASES; ++ph) { a.ph_lo = ph; a.ph_hi = ph + 1;
        hipLaunchKernelGGL(fwd_megakernel, dim3(grid), dim3(512), LDS_BYTES, stream, a); }
#endif
}
```

```cpp
#include <hip/hip_runtime.h>
#include <hip/hip_cooperative_groups.h>
#include <cstdio>
#include <cstdint>
namespace cg = cooperative_groups;

#ifndef N_LAUNCH_MODE
#define N_LAUNCH_MODE 1
#endif

#define LAS __attribute__((address_space(3)))
typedef unsigned short bf16_t;
typedef short bf16x8 __attribute__((ext_vector_type(8)));
typedef float f32x4 __attribute__((ext_vector_type(4)));
typedef float f32x2 __attribute__((ext_vector_type(2)));
typedef unsigned u32x4 __attribute__((ext_vector_type(4)));
typedef unsigned u32x2 __attribute__((ext_vector_type(2)));

constexpr int NTOK = 16384, DM = 2048, SEQ = 2048, NB = 8;
constexpr int INP = 5632;
constexpr int RW = 1536, NH = 24;
constexpr int R_OFF = 512, K_OFF = 2048, V_OFF = 3584, G_OFF = 5120;
constexpr int DFF = 5632;
constexpr float ALPHA = 1.189207115002721f;
constexpr float LN_EPS = 1e-5f, GN_EPS = 64e-5f;

constexpr size_t MiB = 1048576;
constexpr size_t WS_RA    = 0;
constexpr size_t WS_XB    = WS_RA;
constexpr size_t WS_WINT  = 88 * MiB + 176 * MiB;
constexpr size_t WS_AMIX  = WS_RA;
constexpr size_t WS_DFTM  = WS_RA + 64 * MiB;
constexpr size_t WS_WOUTT = WS_RA + 80 * MiB;
constexpr size_t WS_WGUT  = WS_RA;
constexpr size_t WS_PROJ  = 88 * MiB;
constexpr size_t WS_FFA   = WS_PROJ;
constexpr size_t WS_OUT5  = WS_PROJ + 176 * MiB;
constexpr size_t WS_H     = WS_OUT5;
constexpr size_t WS_HB    = WS_OUT5 + 128 * MiB;
constexpr size_t WS_SMALL = WS_OUT5 + 240 * MiB;
constexpr size_t WS_WLT   = WS_SMALL;
constexpr size_t WS_CDFT  = WS_SMALL + 4 * MiB;
constexpr size_t WS_BIAS  = WS_SMALL + 5 * MiB;
constexpr size_t WS_BAR   = WS_BIAS + 65536;
constexpr size_t WS_END   = WS_SMALL + 6 * MiB;
constexpr size_t DO_Y = 0, DO_WDNT = 48 * MiB, DO_FABT = 96 * MiB, DO_ALORA = 0;
constexpr size_t OUT5_STRIDE = (size_t)NTOK * RW;

struct Args {
    const float* in[25];
    float* out;
    unsigned char* ws;
    int ph_lo, ph_hi;
};

typedef __bf16 bf16v2 __attribute__((ext_vector_type(2)));
__device__ __forceinline__ unsigned cvt_pk_bf16(float lo, float hi) { const f32x2 v = {lo, hi}; return __builtin_bit_cast(unsigned, __builtin_convertvector(v, bf16v2)); }
__device__ __forceinline__ float bf2f(bf16_t h) { return __uint_as_float(((unsigned)h) << 16); }
__device__ __forceinline__ bf16_t f2bf(float f) { return (bf16_t)(cvt_pk_bf16(f, 0.f) & 0xffffu); }
__device__ __forceinline__ float wave_sum(float v) {
#pragma unroll
    for (int o = 1; o < 64; o <<= 1) v += __shfl_xor(v, o);
    return v;
}
__device__ __forceinline__ float wave_sum_dpp(float v) {
    v += __builtin_bit_cast(float, __builtin_amdgcn_update_dpp(0, __builtin_bit_cast(int, v), 0xB1, 0xf, 0xf, true));
    v += __builtin_bit_cast(float, __builtin_amdgcn_update_dpp(0, __builtin_bit_cast(int, v), 0x4E, 0xf, 0xf, true));
    v += __builtin_bit_cast(float, __builtin_amdgcn_update_dpp(0, __builtin_bit_cast(int, v), 0x141, 0xf, 0xf, true));
    v += __builtin_bit_cast(float, __builtin_amdgcn_update_dpp(0, __builtin_bit_cast(int, v), 0x140, 0xf, 0xf, true));
    v += __builtin_bit_cast(float, __builtin_amdgcn_update_dpp(0, __builtin_bit_cast(int, v), 0x142, 0xa, 0xf, false));
    v += __builtin_bit_cast(float, __builtin_amdgcn_update_dpp(0, __builtin_bit_cast(int, v), 0x143, 0xc, 0xf, false));
    return __builtin_bit_cast(float, __builtin_amdgcn_readlane(__builtin_bit_cast(int, v), 63));
}
__device__ __forceinline__ float sigmoidf_(float z) { return __builtin_amdgcn_rcpf(1.0f + __expf(-z)); }
#define LDS_WAIT() asm volatile("s_waitcnt lgkmcnt(0)" ::: "memory")
#define RAW_BARRIER() do { asm volatile("s_waitcnt lgkmcnt(0)" ::: "memory"); __builtin_amdgcn_s_barrier(); asm volatile("" ::: "memory"); } while (0)
constexpr int INP_ = 5632, SEQ_ = 2048;
__device__ __forceinline__ float shifted(const bf16_t* p, int t, float mu) {
    const float fp = t > 0 ? 1.0f : 0.0f, fn = t < SEQ_ - 1 ? 1.0f : 0.0f;
    const bf16_t* q0 = t > 0 ? p - INP_ : p; const bf16_t* q1 = t < SEQ_ - 1 ? p + INP_ : p;
    const float p0 = bf2f(p[0]), pp = bf2f(q0[0]) * fp, pn = bf2f(q1[0]) * fn;
    return p0 + (0.5f * (pp + pn) - p0) * mu;
}


namespace pg8 {
constexpr int BM = 256, BK = 64, HALF = 128, HTB = HALF * BK * 2, STAGE_BYTES = 8 * HTB, NXCD = 8, WGM = 8;
__host__ __device__ __forceinline__ int lds_byte(int r, int c) { const int st = (r >> 4) * 2 + (c >> 5), rr = r & 15, cc = c & 31, ob = rr * 64 + cc * 2; return st * 1024 + (ob ^ (((ob >> 9) & 1) << 5)); }
__host__ __device__ __forceinline__ void stage_rc(int b, int& R, int& C) { const int st = b / 1024, sb = b % 1024, swz = sb ^ (((sb >> 9) & 1) << 5); R = (st >> 1) * 16 + swz / 64; C = (st & 1) * 32 + (swz % 64) / 2; }
__host__ __device__ __forceinline__ int perm32(int rho) { const int n = rho >> 4, i = rho & 15; return 8 * (i >> 2) + 4 * n + (i & 3); }
struct Unit { int pm, pn; };

template <int MODE> struct Order {
    int nM, nN, nwg, G, c;
    const char* A; const char* B; size_t tA, tB;
    __device__ void init(int M, int N, int G_, int c_, const void* A_, int lda, const void* B_, int ldb) {
        nM = M / BM; nN = N / BM; nwg = nM * nN; G = G_; c = c_; A = (const char*)A_; B = (const char*)B_; tA = (size_t)BM * lda * 2; tB = (size_t)BM * ldb * 2; }
    __device__ bool next(int i, Unit& u) const {
        const long L = (long)i * G + c; if (L >= nwg) return false;
        int wgid = (int)L; { const int q = nwg / NXCD, r = nwg % NXCD, xcd = wgid % NXCD, off = wgid / NXCD; wgid = (xcd < r ? xcd * (q + 1) : r * (q + 1) + (xcd - r) * q) + off; }
        const int nig = WGM * nN, gid = wgid / nig, fm = gid * WGM, gsz = (nM - fm) < WGM ? (nM - fm) : WGM;
        u.pm = fm + ((wgid % nig) % gsz); u.pn = (wgid % nig) / gsz; return true;
    }
    __device__ __forceinline__ const char* pa(const Unit& u) const {
        if (MODE == 1) return A + (size_t)u.pm * tA + (u.pn >= 24 ? 512 : 0);
        if (MODE == 3) return A + (size_t)u.pm * tA + (u.pn >= 12 ? 256 : 0);
        if (MODE == 2) return A + (size_t)(u.pm & 7) * tA;
        return A + (size_t)u.pm * tA; }
    __device__ __forceinline__ const char* pb(const Unit& u) const {
        if (MODE == 2) return B + (size_t)(u.pm >> 3) * ((size_t)512 * 4096 * 2) + (size_t)u.pn * tB;
        return B + (size_t)u.pn * tB; }
};

struct EpiBf16 {
    static constexpr bool PERM = true;
    bf16_t* O; int ldc;
    __device__ __forceinline__ void operator()(const f32x4 (&acc)[2][2][4][2], const Unit& u, int wr, int wc, int fr, int fq) const {
        const int row0 = u.pm * BM + wr * 64 + fr, col0 = u.pn * BM + wc * 32 + 8 * fq;
#pragma unroll
        for (int ai = 0; ai < 2; ++ai)
#pragma unroll
            for (int m = 0; m < 4; ++m) { bf16_t* rowp = O + (size_t)(row0 + ai * HALF + m * 16) * ldc + col0;
#pragma unroll
                for (int bj = 0; bj < 2; ++bj) { const f32x4 v0 = acc[ai][bj][m][0], v1 = acc[ai][bj][m][1];
                    u32x4 w; w.x = cvt_pk_bf16(v0[0], v0[1]); w.y = cvt_pk_bf16(v0[2], v0[3]); w.z = cvt_pk_bf16(v1[0], v1[1]); w.w = cvt_pk_bf16(v1[2], v1[3]);
                    *(u32x4*)(rowp + bj * HALF) = w; } }
    }
};
struct EpiLora {
    static constexpr bool PERM = true;
    bf16_t* O; const float* bias; int qoff;
    __device__ __forceinline__ void operator()(const f32x4 (&acc)[2][2][4][2], const Unit& u, int wr, int wc, int fr, int fq) const {
        const int q = u.pn / 6 + qoff, cb = (u.pn % 6) * BM + wc * 32 + 8 * fq;
        const int row0 = u.pm * BM + wr * 64 + fr;
        bf16_t* base = O + (size_t)q * OUT5_STRIDE + cb;
        const float* bp = bias + (q & 3) * RW + cb;
        const float sc = (q < 2) ? -0.6065306597126334f : 1.0f;
#pragma unroll
        for (int ai = 0; ai < 2; ++ai)
#pragma unroll
            for (int m = 0; m < 4; ++m) { bf16_t* rowp = base + (size_t)(row0 + ai * HALF + m * 16) * RW;
#pragma unroll
                for (int bj = 0; bj < 2; ++bj) { f32x4 v0 = acc[ai][bj][m][0], v1 = acc[ai][bj][m][1];
                    if (q < 4) { const f32x4 c0 = *(const f32x4*)(bp + bj * HALF), c1 = *(const f32x4*)(bp + bj * HALF + 4);
#pragma unroll
                        for (int j = 0; j < 4; ++j) { v0[j] = sc * sigmoidf_(v0[j] + c0[j]); v1[j] = sc * sigmoidf_(v1[j] + c1[j]); } }
                    u32x4 w; w.x = cvt_pk_bf16(v0[0], v0[1]); w.y = cvt_pk_bf16(v0[2], v0[3]); w.z = cvt_pk_bf16(v1[0], v1[1]); w.w = cvt_pk_bf16(v1[2], v1[3]);
                    *(u32x4*)(rowp + bj * HALF) = w; }
                asm volatile("" ::: "memory"); }
    }
};
struct EpiCdft {
    static constexpr bool PERM = true;
    bf16_t* O;
    __device__ __forceinline__ void operator()(const f32x4 (&acc)[2][2][4][2], const Unit& u, int wr, int wc, int fr, int fq) const {
        const int row0 = u.pm * BM + wr * 64 + fr, tok0 = u.pn * BM + wc * 32 + 8 * fq;
        const int b = tok0 >> 11, pos0 = tok0 & 2047;
#pragma unroll
        for (int ai = 0; ai < 2; ++ai)
#pragma unroll
            for (int m = 0; m < 4; ++m) { const int mm = row0 + ai * HALF + m * 16, part = mm >> 9, np = mm & 511;
                bf16_t* rowp = O + ((size_t)(b * 512 + np) * 4096 + part * 2048 + pos0);
#pragma unroll
                for (int bj = 0; bj < 2; ++bj) { const f32x4 v0 = acc[ai][bj][m][0], v1 = acc[ai][bj][m][1];
                    u32x4 w; w.x = cvt_pk_bf16(v0[0], v0[1]); w.y = cvt_pk_bf16(v0[2], v0[3]); w.z = cvt_pk_bf16(v1[0], v1[1]); w.w = cvt_pk_bf16(v1[2], v1[3]);
                    *(u32x4*)(rowp + bj * HALF) = w; } }
    }
};
struct EpiResF32 {
    static constexpr bool PERM = false;
    float* C; const float* res;
    __device__ __forceinline__ void operator()(const f32x4 (&acc)[2][2][4][2], const Unit& u, int wr, int wc, int fr, int fq) const {
        const int row0 = u.pm * BM + wr * 64 + fr, col0 = u.pn * BM + wc * 32 + 4 * fq;
#pragma unroll
        for (int ai = 0; ai < 2; ++ai)
#pragma unroll
            for (int m = 0; m < 4; ++m) { const size_t off = (size_t)(row0 + ai * HALF + m * 16) * DM + col0;
#pragma unroll
                for (int bj = 0; bj < 2; ++bj)
#pragma unroll
                    for (int n = 0; n < 2; ++n) { const f32x4 rs = *(const f32x4*)(res + off + bj * HALF + n * 16); *(f32x4*)(C + off + bj * HALF + n * 16) = acc[ai][bj][m][n] + ALPHA * rs; }
                asm volatile("" ::: "memory"); }
    }
};
struct EpiResToBf16 {
    static constexpr bool PERM = true;
    bf16_t* O; const float* res;
    __device__ __forceinline__ void operator()(const f32x4 (&acc)[2][2][4][2], const Unit& u, int wr, int wc, int fr, int fq) const {
        const int row0 = u.pm * BM + wr * 64 + fr, col0 = u.pn * BM + wc * 32 + 8 * fq;
#pragma unroll
        for (int ai = 0; ai < 2; ++ai)
#pragma unroll
            for (int m = 0; m < 4; ++m) { const size_t off = (size_t)(row0 + ai * HALF + m * 16) * DM + col0;
#pragma unroll
                for (int bj = 0; bj < 2; ++bj) { const f32x4 r0 = __builtin_nontemporal_load((const f32x4*)(res + off + bj * HALF)), r1 = __builtin_nontemporal_load((const f32x4*)(res + off + bj * HALF + 4));
                    const f32x4 v0 = acc[ai][bj][m][0] + ALPHA * r0, v1 = acc[ai][bj][m][1] + ALPHA * r1;
                    u32x4 w; w.x = cvt_pk_bf16(v0[0], v0[1]); w.y = cvt_pk_bf16(v0[2], v0[3]); w.z = cvt_pk_bf16(v1[0], v1[1]); w.w = cvt_pk_bf16(v1[2], v1[3]);
                    *(u32x4*)(O + off + bj * HALF) = w; }
                asm volatile("" ::: "memory"); }
    }
};
struct EpiResBfToBf {
    static constexpr bool PERM = true;
    bf16_t* O; const bf16_t* res;
    __device__ __forceinline__ void operator()(const f32x4 (&acc)[2][2][4][2], const Unit& u, int wr, int wc, int fr, int fq) const {
        const int row0 = u.pm * BM + wr * 64 + fr, col0 = u.pn * BM + wc * 32 + 8 * fq;
#pragma unroll
        for (int ai = 0; ai < 2; ++ai)
#pragma unroll
            for (int m = 0; m < 4; ++m) { const size_t off = (size_t)(row0 + ai * HALF + m * 16) * DM + col0;
#pragma unroll
                for (int bj = 0; bj < 2; ++bj) { const u32x4 rb = *(const u32x4*)(res + off + bj * HALF);
                    const f32x4 r0 = {__uint_as_float(rb.x << 16), __uint_as_float(rb.x & 0xffff0000u), __uint_as_float(rb.y << 16), __uint_as_float(rb.y & 0xffff0000u)};
                    const f32x4 r1 = {__uint_as_float(rb.z << 16), __uint_as_float(rb.z & 0xffff0000u), __uint_as_float(rb.w << 16), __uint_as_float(rb.w & 0xffff0000u)};
                    const f32x4 v0 = acc[ai][bj][m][0] + ALPHA * r0, v1 = acc[ai][bj][m][1] + ALPHA * r1;
                    u32x4 w; w.x = cvt_pk_bf16(v0[0], v0[1]); w.y = cvt_pk_bf16(v0[2], v0[3]); w.z = cvt_pk_bf16(v1[0], v1[1]); w.w = cvt_pk_bf16(v1[2], v1[3]);
                    *(u32x4*)(O + off + bj * HALF) = w; }
                asm volatile("" ::: "memory"); }
    }
};
struct EpiResBf16 {
    static constexpr bool PERM = false;
    float* C; const bf16_t* res;
    __device__ __forceinline__ void operator()(const f32x4 (&acc)[2][2][4][2], const Unit& u, int wr, int wc, int fr, int fq) const {
        const int row0 = u.pm * BM + wr * 64 + fr, col0 = u.pn * BM + wc * 32 + 4 * fq;
#pragma unroll
        for (int ai = 0; ai < 2; ++ai)
#pragma unroll
            for (int m = 0; m < 4; ++m) { const size_t off = (size_t)(row0 + ai * HALF + m * 16) * DM + col0;
#pragma unroll
                for (int bj = 0; bj < 2; ++bj)
#pragma unroll
                    for (int n = 0; n < 2; ++n) { const u32x2 rb = *(const u32x2*)(res + off + bj * HALF + n * 16);
                        const f32x4 rs = {__uint_as_float(rb.x << 16), __uint_as_float(rb.x & 0xffff0000u), __uint_as_float(rb.y << 16), __uint_as_float(rb.y & 0xffff0000u)};
                        *(f32x4*)(C + off + bj * HALF + n * 16) = acc[ai][bj][m][n] + ALPHA * rs; }
                asm volatile("" ::: "memory"); }
    }
};
struct EpiSwiglu {
    static constexpr bool PERM = true;
    bf16_t* O;
    __device__ __forceinline__ void operator()(const f32x4 (&acc)[2][2][4][2], const Unit& u, int wr, int wc, int fr, int fq) const {
        const int row0 = u.pm * BM + wr * 64 + fr, col0 = u.pn * HALF + wc * 32 + 8 * fq;
#pragma unroll
        for (int ai = 0; ai < 2; ++ai)
#pragma unroll
            for (int m = 0; m < 4; ++m) { bf16_t* rowp = O + (size_t)(row0 + ai * HALF + m * 16) * DFF + col0;
                f32x4 o0, o1;
#pragma unroll
                for (int j = 0; j < 4; ++j) { const float g0 = acc[ai][0][m][0][j], g1 = acc[ai][0][m][1][j];
                    o0[j] = g0 * sigmoidf_(g0) * acc[ai][1][m][0][j]; o1[j] = g1 * sigmoidf_(g1) * acc[ai][1][m][1][j]; }
                u32x4 w; w.x = cvt_pk_bf16(o0[0], o0[1]); w.y = cvt_pk_bf16(o0[2], o0[3]); w.z = cvt_pk_bf16(o1[0], o1[1]); w.w = cvt_pk_bf16(o1[2], o1[3]);
                *(u32x4*)rowp = w; }
    }
};

template <class Epi, class Sched>
__device__ __forceinline__ void gemm_phase(LAS unsigned char* lds, const int K, const int lda, const int ldb, const Sched& S, const Epi& E) {
    const int tid = threadIdx.x, wid = __builtin_amdgcn_readfirstlane(tid >> 6), lane = tid & 63, wr = wid >> 2, wc = wid & 3, fr = lane & 15, fq = lane >> 4;
    const int nt = K / BK;
    unsigned voffA[2], voffB[2];
#pragma unroll
    for (int i = 0; i < 2; ++i) { int R, C; stage_rc(tid * 16 + i * 8192, R, C); const int Rb = Epi::PERM ? ((R & ~31) + perm32(R & 31)) : R;
        voffA[i] = (unsigned)(R * lda + C) * 2u; voffB[i] = (unsigned)(Rb * ldb + C) * 2u; }
    const size_t kstep = (size_t)(BK * 2);
    const size_t hstepA = (size_t)HALF * lda * 2, hstepB = (size_t)HALF * ldb * 2;
    const unsigned ldsw = (unsigned)wid * 1024u;
    const int aoff = lds_byte(wr * 64 + fr, fq * 8), boff = lds_byte(wc * 32 + fr, fq * 8);
#define PG8_SA(b, h) (((b) * 2 + (h)) * HTB)
#define PG8_SB(b, h) ((4 + (b) * 2 + (h)) * HTB)
#define PG8_STAGE(bufoff, gbase, voff) do { _Pragma("unroll") for (int _i = 0; _i < 2; ++_i) \
        __builtin_amdgcn_global_load_lds((const unsigned*)((const char*)(gbase) + (voff)[_i]), (LAS unsigned*)(lds + (bufoff) + ldsw + _i * 8192), 16, 0, 0); } while (0)
#define PG8_LDA(dst, b, h) do { _Pragma("unroll") for (int m = 0; m < 4; ++m) _Pragma("unroll") for (int k = 0; k < 2; ++k) dst[m][k] = *(const LAS bf16x8*)(lds + PG8_SA(b, h) + aoff + m * 2048 + k * 1024); } while (0)
#define PG8_LDB(dst, b, h) do { _Pragma("unroll") for (int n = 0; n < 2; ++n) _Pragma("unroll") for (int k = 0; k < 2; ++k) dst[n][k] = *(const LAS bf16x8*)(lds + PG8_SB(b, h) + boff + n * 2048 + k * 1024); } while (0)
#define PG8_MMA(ai, bj, At, Bt) do { __builtin_amdgcn_s_setprio(1); _Pragma("unroll") for (int m = 0; m < 4; ++m) _Pragma("unroll") for (int n = 0; n < 2; ++n) _Pragma("unroll") for (int k = 0; k < 2; ++k) \
        acc[ai][bj][m][n] = __builtin_amdgcn_mfma_f32_16x16x32_bf16(Bt[n][k], At[m][k], acc[ai][bj][m][n], 0, 0, 0); __builtin_amdgcn_s_setprio(0); } while (0)
#define PG8_WAIT_V(n) asm volatile("s_waitcnt vmcnt(" #n ")" ::: "memory")
#define PG8_WAIT_L(n) asm volatile("s_waitcnt lgkmcnt(" #n ")" ::: "memory")
#define PG8_BAR __builtin_amdgcn_s_barrier()
#define PG8_SCHED __builtin_amdgcn_sched_barrier(0)
    Unit cur, nxt; int ui = 0;
    if (!S.next(0, cur)) return;
    f32x4 acc[2][2][4][2];
#pragma unroll
    for (int a = 0; a < 2; ++a)
#pragma unroll
        for (int b = 0; b < 2; ++b)
#pragma unroll
            for (int m = 0; m < 4; ++m)
#pragma unroll
                for (int n = 0; n < 2; ++n) acc[a][b][m][n] = (f32x4){0.f, 0.f, 0.f, 0.f};
    bf16x8 At[4][2], B0[2][2], B1[2][2];
    const char* cA = S.pa(cur); const char* cB = S.pb(cur);
    PG8_STAGE(PG8_SB(0, 0), cB, voffB); PG8_STAGE(PG8_SB(0, 1), cB + hstepB, voffB); PG8_STAGE(PG8_SA(0, 0), cA, voffA); PG8_STAGE(PG8_SA(0, 1), cA + hstepA, voffA);
    if (wr == 1) PG8_BAR;
    PG8_WAIT_V(2); PG8_BAR;
    PG8_STAGE(PG8_SB(1, 0), cB + kstep, voffB); PG8_STAGE(PG8_SA(1, 0), cA + kstep, voffA); PG8_STAGE(PG8_SB(1, 1), cB + hstepB + kstep, voffB);
    PG8_WAIT_V(6); PG8_BAR;
    for (;;) {
        const bool has_next = S.next(ui + 1, nxt);
        const char* nA = has_next ? S.pa(nxt) : cA; const char* nB = has_next ? S.pb(nxt) : cB;
        for (int t = 0; t < nt; t += 2) {
            const bool last = (t == nt - 2);
            const char* a1 = cA + (size_t)(t + 1) * kstep;
            const char* a2 = last ? nA : cA + (size_t)(t + 2) * kstep; const char* b2 = last ? nB : cB + (size_t)(t + 2) * kstep;
            const char* a3 = a2 + kstep; const char* b3 = b2 + kstep;
            PG8_LDB(B0, 0, 0); PG8_LDB(B1, 0, 1); PG8_SCHED; PG8_LDA(At, 0, 0); PG8_STAGE(PG8_SA(1, 1), a1 + hstepA, voffA);
            PG8_WAIT_V(8); PG8_WAIT_L(0); PG8_BAR; PG8_MMA(0, 0, At, B0); PG8_MMA(0, 1, At, B1); PG8_BAR; PG8_SCHED;
            PG8_LDA(At, 0, 1); PG8_STAGE(PG8_SB(0, 0), b2, voffB); PG8_STAGE(PG8_SB(0, 1), b2 + hstepB, voffB); PG8_STAGE(PG8_SA(0, 0), a2, voffA);
            PG8_WAIT_V(8); PG8_WAIT_L(0); PG8_BAR; PG8_MMA(1, 0, At, B0); PG8_MMA(1, 1, At, B1); PG8_BAR; PG8_SCHED;
            PG8_LDB(B0, 1, 0); PG8_LDB(B1, 1, 1); PG8_SCHED; PG8_LDA(At, 1, 0); PG8_STAGE(PG8_SA(0, 1), a2 + hstepA, voffA);
            PG8_WAIT_V(8); PG8_WAIT_L(0); PG8_BAR; PG8_MMA(0, 0, At, B0); PG8_MMA(0, 1, At, B1); PG8_BAR; PG8_SCHED;
            PG8_LDA(At, 1, 1); PG8_STAGE(PG8_SB(1, 0), b3, voffB); PG8_STAGE(PG8_SB(1, 1), b3 + hstepB, voffB); PG8_STAGE(PG8_SA(1, 0), a3, voffA);
            PG8_WAIT_V(8); PG8_WAIT_L(0); PG8_BAR; PG8_MMA(1, 0, At, B0); PG8_MMA(1, 1, At, B1); PG8_BAR; PG8_SCHED;
        }
        if (wr == 0) PG8_BAR;
        E(acc, cur, wr, wc, fr, fq);
        if (!has_next) break;
#pragma unroll
        for (int a = 0; a < 2; ++a)
#pragma unroll
            for (int b = 0; b < 2; ++b)
#pragma unroll
                for (int m = 0; m < 4; ++m)
#pragma unroll
                    for (int n = 0; n < 2; ++n) acc[a][b][m][n] = (f32x4){0.f, 0.f, 0.f, 0.f};
        cur = nxt; cA = nA; cB = nB; ++ui;
        if (wr == 1) PG8_BAR;
    }
    PG8_WAIT_V(0);
    PG8_BAR;
#undef PG8_SA
#undef PG8_SB
#undef PG8_STAGE
#undef PG8_LDA
#undef PG8_LDB
#undef PG8_MMA
#undef PG8_WAIT_V
#undef PG8_WAIT_L
#undef PG8_BAR
#undef PG8_SCHED
}
}

template <int MODE> __device__ __forceinline__ void tr_item(const float* W, int K, int N, bf16_t* WT, int ldd, LAS float* scr, int item, int lane) {
    const int nblk = N / 32, kb = item / nblk, nb = item % nblk, k0 = 64 * kb, n0 = 32 * nb;
    float tv[32];
#pragma unroll
    for (int i = 0; i < 32; ++i) tv[i] = __builtin_nontemporal_load(W + (size_t)(k0 + 2 * i + (lane >> 5)) * N + n0 + (lane & 31));
#pragma unroll
    for (int i = 0; i < 32; ++i) scr[(2 * i + (lane >> 5)) * 33 + (lane & 31)] = tv[i];
    LDS_WAIT();
    const int c = lane & 7;
#pragma unroll
    for (int j = 0; j < 4; ++j) { const int n = n0 + (lane >> 3) + 8 * j; const LAS float* s = scr + (8 * c) * 33 + (n - n0);
        u32x4 o; o.x = cvt_pk_bf16(s[0 * 33], s[1 * 33]); o.y = cvt_pk_bf16(s[2 * 33], s[3 * 33]); o.z = cvt_pk_bf16(s[4 * 33], s[5 * 33]); o.w = cvt_pk_bf16(s[6 * 33], s[7 * 33]);
        const int dr = (MODE == 0) ? n : (256 * (n >> 7) + (MODE == 2 ? 128 : 0) + (n & 127));
        *(u32x4*)(WT + (size_t)dr * ldd + k0 + 8 * c) = o; }
    LDS_WAIT();
}

struct Ctx {
    const Args& a; LAS unsigned char* lds; int lane, wave, bid, G, gw, NGW, gtid, GT;
    __device__ __forceinline__ Ctx(const Args& a_, LAS unsigned char* l) : a(a_), lds(l), lane(threadIdx.x & 63), wave(__builtin_amdgcn_readfirstlane(threadIdx.x >> 6)), bid(blockIdx.x), G(gridDim.x),
        gw(blockIdx.x * 8 + wave), NGW(gridDim.x * 8), gtid(blockIdx.x * 512 + threadIdx.x), GT(gridDim.x * 512) {}
};

__device__ __forceinline__ void phase0(const Ctx& c) {
    const float* x = c.a.in[0];
    bf16_t* xb = (bf16_t*)(c.a.ws + WS_XB);
    for (size_t i0 = c.gtid; i0 < (size_t)NTOK * DM / 8; i0 += (size_t)4 * c.GT) {
        f32x4 p[4], q[4];
#pragma unroll
        for (int u = 0; u < 4; ++u) { const size_t i = i0 + (size_t)u * c.GT; p[u] = __builtin_nontemporal_load((const f32x4*)x + 2 * i); q[u] = __builtin_nontemporal_load((const f32x4*)x + 2 * i + 1); }
#pragma unroll
        for (int u = 0; u < 4; ++u) { const size_t i = i0 + (size_t)u * c.GT;
            u32x4 o; o.x = cvt_pk_bf16(p[u][0], p[u][1]); o.y = cvt_pk_bf16(p[u][2], p[u][3]); o.z = cvt_pk_bf16(q[u][0], q[u][1]); o.w = cvt_pk_bf16(q[u][2], q[u][3]); ((u32x4*)xb)[i] = o; } }
    LAS float* scr = (LAS float*)(c.lds + c.wave * 16384);
    bf16_t* wint = (bf16_t*)(c.a.ws + WS_WINT);
    for (int it = c.gw; it < 32 * 175; it += c.NGW) tr_item<0>(c.a.in[1], DM, 5600, wint, DM, scr, it, c.lane);
    for (int i = c.gtid; i < 32 * DM / 8; i += c.GT) ((u32x4*)(wint + (size_t)5600 * DM))[i] = (u32x4){0u, 0u, 0u, 0u};
}

__device__ __forceinline__ void phase2(const Ctx& c) {
    const bf16_t* proj = (const bf16_t*)(c.a.ws + WS_PROJ);
    bf16_t* al = (bf16_t*)((unsigned char*)c.a.out + DO_ALORA);
    const float* mu = c.a.in[2];
    for (int i = c.gtid; i < NTOK * 64; i += c.GT) { const int tok = i >> 6, g = i & 63, t = tok & (SEQ - 1);
        u32x4 w = {0u, 0u, 0u, 0u};
        if (g < 60) { const int col = (g < 32) ? (5344 + 8 * g) : (G_OFF + 8 * (g - 32));
            const bf16_t* p0 = proj + (size_t)tok * INP + col; const bf16_t* pp = t > 0 ? p0 - INP : p0; const bf16_t* pn = t < SEQ - 1 ? p0 + INP : p0;
            const float fp = t > 0 ? 1.0f : 0.0f, fn = t < SEQ - 1 ? 1.0f : 0.0f;
            float x0[8], x1[8], x2[8], o[8];
            { const u32x4 w0 = *(const u32x4*)p0, w1 = *(const u32x4*)pp, w2 = *(const u32x4*)pn;
#pragma unroll
              for (int e = 0; e < 4; ++e) { x0[2 * e] = __uint_as_float(w0[e] << 16); x0[2 * e + 1] = __uint_as_float(w0[e] & 0xffff0000u); x1[2 * e] = __uint_as_float(w1[e] << 16); x1[2 * e + 1] = __uint_as_float(w1[e] & 0xffff0000u);
                  x2[2 * e] = __uint_as_float(w2[e] << 16); x2[2 * e + 1] = __uint_as_float(w2[e] & 0xffff0000u); } }
            const f32x4 m0 = *(const f32x4*)(mu + col - 512), m1 = *(const f32x4*)(mu + col - 512 + 4);
#pragma unroll
            for (int e = 0; e < 8; ++e) { const float s = x0[e] + (0.5f * (x1[e] * fp + x2[e] * fn) - x0[e]) * (e < 4 ? m0[e] : m1[e - 4]);
                o[e] = (g < 16) ? (1.0f - 2.0f * __builtin_amdgcn_rcpf(1.0f + __expf(2.0f * s))) : (g < 32) ? s : sigmoidf_(s); }
            w.x = cvt_pk_bf16(o[0], o[1]); w.y = cvt_pk_bf16(o[2], o[3]); w.z = cvt_pk_bf16(o[4], o[5]); w.w = cvt_pk_bf16(o[6], o[7]); }
        ((u32x4*)al)[i] = w; }
}
__device__ __forceinline__ void phase1_fill(const Args& a, LAS unsigned char* lds, int idx, int n) {
    const int lane = threadIdx.x & 63, wave = __builtin_amdgcn_readfirstlane(threadIdx.x >> 6), gtid = idx * 512 + threadIdx.x, GT = n * 512, gw = idx * 8 + wave, NGW = n * 8;
    LAS float* T = (LAS float*)(lds + 131072);
    for (int m = threadIdx.x; m < 2048; m += 512) T[m] = cospif((float)m * (1.0f / 1024.0f)) * 0.022097086912079608f;
    __syncthreads();
    bf16_t* dm = (bf16_t*)(a.ws + WS_DFTM);
    for (int i = gtid; i < 2048 * 4096 / 8; i += GT) { const int sp = i >> 9, k0 = (i & 511) * 8; float v[8];
#pragma unroll
        for (int j = 0; j < 8; ++j) { const int k = k0 + j; v[j] = T[(sp * (k & 2047) + (k < 2048 ? 0 : 512)) & 2047]; }
        u32x4 o; o.x = cvt_pk_bf16(v[0], v[1]); o.y = cvt_pk_bf16(v[2], v[3]); o.z = cvt_pk_bf16(v[4], v[5]); o.w = cvt_pk_bf16(v[6], v[7]); ((u32x4*)dm)[i] = o; }
    __syncthreads();
    bf16_t* wlt = (bf16_t*)(a.ws + WS_WLT);
    for (int i = gtid; i < 6144 * 128; i += GT) { const int n = i >> 7, k = i & 127, q = n / RW, ch = n % RW; float v = 0.f;
        if ((k >> 6) == (q & 1)) { const float* up = (q == 0) ? a.in[3] : (q == 1) ? a.in[4] : (q == 2) ? a.in[7] : a.in[8]; v = up[(size_t)(k & 63) * RW + ch]; }
        wlt[i] = f2bf(v); }
    bf16_t* wgt = (bf16_t*)(a.ws + WS_WLT + 2 * MiB);
    for (int i = gtid; i < 1536 * 256; i += GT) { const int ch = i >> 8, k = i & 255; wgt[i] = f2bf(k < 224 ? a.in[11][(size_t)k * RW + ch] : 0.f); }
    { float* bs = (float*)(a.ws + WS_BIAS);
      for (int i = gtid; i < RW; i += GT) { bs[i] = a.in[5][i]; bs[RW + i] = a.in[6][i]; bs[2 * RW + i] = a.in[9][i]; bs[3 * RW + i] = a.in[10][i]; } }
    bf16_t* cd = (bf16_t*)(a.ws + WS_CDFT);
    for (int i = gtid; i < 1024 * 512; i += GT) { const int m = i >> 9, k = i & 511, part = m >> 9, g = (m >> 7) & 3, cp = m & 127, g2 = k >> 7, cc = k & 127; float v = 0.f;
        if (g == g2) { const float ang = (float)((cc * cp) & 127) * (1.0f / 64.0f); v = (part ? sinpif(ang) : cospif(ang)) * 0.08838834764831845f; }
        cd[i] = f2bf(v); }
    LAS float* scr = (LAS float*)(lds + wave * 16384);
    for (int it = gw; it < 32 * 64; it += NGW) tr_item<0>(a.in[17], DM, DM, (bf16_t*)(a.ws + WS_WOUTT), DM, scr, it, lane);
}

typedef short bf16x4 __attribute__((ext_vector_type(4)));
constexpr int YBUF = 64 * 144;
constexpr int RS = 136, RS2 = 40;
constexpr int SL_AT = 0, SL_RT = 2176, SL_BT = 4352, SL_TT = 4352, SL_KT = 6528, SL_BH = 8704, SL_KH = 11264, SL_V = 13824, SL_WT = 16384, SLOT = 16640;
__device__ __forceinline__ bf16x4 cvt4(const f32x4 v) { u32x2 w; w.x = cvt_pk_bf16(v[0], v[1]); w.y = cvt_pk_bf16(v[2], v[3]); return __builtin_bit_cast(bf16x4, w); }
__device__ __forceinline__ bf16x8 cat8(const bf16x4 lo, const bf16x4 hi) { return __builtin_shufflevector(lo, hi, 0, 1, 2, 3, 4, 5, 6, 7); }
__device__ __forceinline__ f32x4 mfma16(const bf16x4 a, const bf16x4 b, const f32x4 c) { return __builtin_amdgcn_mfma_f32_16x16x16bf16_1k(a, b, c, 0, 0, 0); }
__device__ __forceinline__ f32x4 mfma32(const bf16x8 a, const bf16x8 b, const f32x4 c) { return __builtin_amdgcn_mfma_f32_16x16x32_bf16(a, b, c, 0, 0, 0); }

__device__ __forceinline__ void scan2_phase(const Args& a, LAS unsigned char* lds) {
    const int bid = blockIdx.x; if (bid >= 192) return;
    const int lane = threadIdx.x & 63, wave = __builtin_amdgcn_readfirstlane(threadIdx.x >> 6), dir = wave >> 2, ws = wave & 3;
    const int b = bid / NH, h = bid % NH, ch = h * 64 + lane, fr = lane & 15, g = lane >> 4, i0 = 16 * ws;
    LAS unsigned char* base = lds + dir * (4 * SLOT);
    const float kk_ = a.in[12][ch], ka_ = a.in[13][ch];
    const float mur = a.in[2][R_OFF - 512 + ch], muk = a.in[2][K_OFF - 512 + ch], muv = a.in[2][V_OFF - 512 + ch];
    const unsigned char* P = a.ws + WS_PROJ + (size_t)b * SEQ * INP * 2;
    const unsigned char* LW = a.ws + WS_OUT5 + ((size_t)dir * OUT5_STRIDE + (size_t)b * SEQ * RW) * 2;
    const unsigned char* AI = a.ws + WS_OUT5 + ((size_t)(2 + dir) * OUT5_STRIDE + (size_t)b * SEQ * RW) * 2;
    const unsigned voK = (unsigned)(K_OFF + ch) * 2u, voC = (unsigned)ch * 2u;
    const long sP = dir ? -(long)(INP * 2) : (long)(INP * 2), sL = dir ? -(long)(RW * 2) : (long)(RW * 2);
    bf16_t* Y = (bf16_t*)((unsigned char*)a.out + DO_Y) + (size_t)b * SEQ * RW + h * 64;
    LAS unsigned char* ybuf = lds + 8 * SLOT + dir * YBUF;
    f32x4 St[4];
#pragma unroll
    for (int jt = 0; jt < 4; ++jt) St[jt] = (f32x4){0.f, 0.f, 0.f, 0.f};
    unsigned rru[18], kru[18], vru[18], lwu[16], aiu[16];
#define LDU16(base, boff) ((unsigned)(*(const bf16_t*)((base) + (boff))))
#define SCAN_LOAD_RAW(cidx) do { \
        const int t0_ = dir ? (SEQ - 16 * (cidx)) : (16 * (cidx) - 1), l0_ = dir ? (SEQ - 1 - 16 * (cidx)) : (16 * (cidx)); \
        const unsigned char* bP_ = P + (long)t0_ * (INP * 2); const unsigned char* bL_ = LW + (long)l0_ * (RW * 2); const unsigned char* bA_ = AI + (long)l0_ * (RW * 2); \
        _Pragma("unroll") for (int i = 0; i < 18; ++i) { const unsigned char* rb = bP_ + sP * i; \
            rru[i] = LDU16(rb, voK - (K_OFF - R_OFF) * 2); kru[i] = LDU16(rb, voK); vru[i] = LDU16(rb, voK + (V_OFF - K_OFF) * 2); } \
        _Pragma("unroll") for (int i = 0; i < 16; ++i) { lwu[i] = LDU16(bL_ + sL * i, voC); aiu[i] = LDU16(bA_ + sL * i, voC); } } while (0)
    SCAN_LOAD_RAW(ws);
    for (int G = 0; G < SEQ / 64; ++G) {
        LAS unsigned char* slot = base + ws * SLOT;
        {
            float rr[18], kr[18], vr[18], lwv[16], aiv[16];
            { const int cidx = 4 * G + ws;
#pragma unroll
              for (int i = 0; i < 18; ++i) { const unsigned m = (i == 0) ? ((cidx == 0) ? 0u : 0xffffffffu) : (i == 17) ? ((cidx == SEQ / 16 - 1) ? 0u : 0xffffffffu) : 0xffffffffu;
                  rr[i] = __uint_as_float((rru[i] << 16) & m); kr[i] = __uint_as_float((kru[i] << 16) & m); vr[i] = __uint_as_float((vru[i] << 16) & m); }
#pragma unroll
              for (int i = 0; i < 16; ++i) { lwv[i] = __uint_as_float(lwu[i] << 16); aiv[i] = __uint_as_float(aiu[i] << 16); } }
            float E[17], Ei[16]; E[0] = 1.0f;
            { float Lc = 0.f;
#pragma unroll
              for (int tt = 0; tt < 16; ++tt) { Lc += lwv[tt] * 1.4426950408889634f; E[tt + 1] = __builtin_amdgcn_exp2f(Lc); Ei[tt] = __builtin_amdgcn_exp2f(-Lc); } }
            const float ET = E[16];
            float bh[16], kh[16], vv[16];
#pragma unroll
            for (int tp = 0; tp < 16; tp += 2) {
                float av[2], bv[2], kv[2], rv[2];
#pragma unroll
                for (int u = 0; u < 2; ++u) { const int tt = tp + u;
                    const float r = rr[tt + 1] + (0.5f * (rr[tt] + rr[tt + 2]) - rr[tt + 1]) * mur;
                    const float k = kr[tt + 1] + (0.5f * (kr[tt] + kr[tt + 2]) - kr[tt + 1]) * muk;
                    const float v = vr[tt + 1] + (0.5f * (vr[tt] + vr[tt + 2]) - vr[tt + 1]) * muv;
                    const float ai = aiv[tt];
                    const float kkr = k * kk_; const float n2 = wave_sum_dpp(kkr * kkr);
                    const float kk = kkr * rsqrtf(fmaxf(n2, 1e-24f));
                    const float kd = k * (1.0f + (ai - 1.0f) * ka_);
                    const float bt = kk * ai * Ei[tt], kt = kd * Ei[tt];
                    av[u] = -kk * E[tt]; bv[u] = bt; kv[u] = kt; rv[u] = r * E[tt + 1];
                    bh[tt] = bt * ET; kh[tt] = kt * ET; vv[tt] = v; }
                const unsigned wa = cvt_pk_bf16(av[0], av[1]), wb = cvt_pk_bf16(bv[0], bv[1]), wk = cvt_pk_bf16(kv[0], kv[1]), wr_ = cvt_pk_bf16(rv[0], rv[1]);
                *(LAS bf16_t*)(slot + SL_AT + tp * RS + lane * 2) = (bf16_t)(wa & 0xffffu); *(LAS bf16_t*)(slot + SL_AT + (tp + 1) * RS + lane * 2) = (bf16_t)(wa >> 16);
                *(LAS bf16_t*)(slot + SL_BT + tp * RS + lane * 2) = (bf16_t)(wb & 0xffffu); *(LAS bf16_t*)(slot + SL_BT + (tp + 1) * RS + lane * 2) = (bf16_t)(wb >> 16);
                *(LAS bf16_t*)(slot + SL_KT + tp * RS + lane * 2) = (bf16_t)(wk & 0xffffu); *(LAS bf16_t*)(slot + SL_KT + (tp + 1) * RS + lane * 2) = (bf16_t)(wk >> 16);
                *(LAS bf16_t*)(slot + SL_RT + tp * RS + lane * 2) = (bf16_t)(wr_ & 0xffffu); *(LAS bf16_t*)(slot + SL_RT + (tp + 1) * RS + lane * 2) = (bf16_t)(wr_ >> 16);
            }
#pragma unroll
            for (int q = 0; q < 4; ++q) { u32x2 w0, w1, w2;
                w0.x = cvt_pk_bf16(bh[4 * q + 0], bh[4 * q + 1]); w0.y = cvt_pk_bf16(bh[4 * q + 2], bh[4 * q + 3]);
                w1.x = cvt_pk_bf16(kh[4 * q + 0], kh[4 * q + 1]); w1.y = cvt_pk_bf16(kh[4 * q + 2], kh[4 * q + 3]);
                w2.x = cvt_pk_bf16(vv[4 * q + 0], vv[4 * q + 1]); w2.y = cvt_pk_bf16(vv[4 * q + 2], vv[4 * q + 3]);
                *(LAS u32x2*)(slot + SL_BH + lane * RS2 + q * 8) = w0; *(LAS u32x2*)(slot + SL_KH + lane * RS2 + q * 8) = w1; *(LAS u32x2*)(slot + SL_V + lane * RS2 + q * 8) = w2; }
            *(LAS float*)(slot + SL_WT + lane * 4) = ET;
        }
        if (G + 1 < SEQ / 64) SCAN_LOAD_RAW(4 * (G + 1) + ws);
        LDS_WAIT(); __builtin_amdgcn_wave_barrier();
        {
            bf16x8 fa[2], fb[2], fk[2], frr[2];
#pragma unroll
            for (int m = 0; m < 2; ++m) { const int off = fr * RS + (32 * m + 8 * g) * 2;
                fa[m] = cat8(*(const LAS bf16x4*)(slot + SL_AT + off), *(const LAS bf16x4*)(slot + SL_AT + off + 8)); fb[m] = cat8(*(const LAS bf16x4*)(slot + SL_BT + off), *(const LAS bf16x4*)(slot + SL_BT + off + 8));
                fk[m] = cat8(*(const LAS bf16x4*)(slot + SL_KT + off), *(const LAS bf16x4*)(slot + SL_KT + off + 8)); frr[m] = cat8(*(const LAS bf16x4*)(slot + SL_RT + off), *(const LAS bf16x4*)(slot + SL_RT + off + 8)); }
            const f32x4 z4 = {0.f, 0.f, 0.f, 0.f};
            f32x4 aP = mfma32(fa[1], fb[1], mfma32(fa[0], fb[0], z4));
            f32x4 aPT = mfma32(fb[1], fa[1], mfma32(fb[0], fa[0], z4));
            f32x4 aKa = mfma32(fk[1], fa[1], mfma32(fk[0], fa[0], z4));
            f32x4 aBr = mfma32(fb[1], frr[1], mfma32(fb[0], frr[0], z4));
            f32x4 aKr = mfma32(fk[1], frr[1], mfma32(fk[0], frr[0], z4));
            f32x4 aU;
#pragma unroll
            for (int jj = 0; jj < 4; ++jj) { const int rw = 4 * g + jj;
                aP[jj] = (fr < rw) ? aP[jj] : 0.f; aPT[jj] = (rw < fr) ? aPT[jj] : 0.f; aKa[jj] = (rw < fr) ? aKa[jj] : 0.f;
                aBr[jj] = (rw <= fr) ? aBr[jj] : 0.f; aKr[jj] = (rw <= fr) ? aKr[jj] : 0.f; aU[jj] = aPT[jj] + ((rw == fr) ? 1.0f : 0.f); }
            const bf16x4 pP = cvt4(aP), pPT = cvt4(aPT);
            const f32x4 aP2 = mfma16(pPT, pP, z4), aPT2 = mfma16(pP, pPT, z4);
            const bf16x4 pP2 = cvt4(aP2), pPT2 = cvt4(aPT2);
            aU = mfma16(pP2, cvt4(aU), aU);
            const f32x4 aP4 = mfma16(pPT2, pP2, z4), aPT4 = mfma16(pP2, pPT2, z4);
            const bf16x4 pP4 = cvt4(aP4), pPT4 = cvt4(aPT4);
            aU = mfma16(pP4, cvt4(aU), aU);
            const f32x4 aP8 = mfma16(pPT4, pP4, z4);
            aU = mfma16(cvt4(aP8), cvt4(aU), aU);
            *(LAS bf16x4*)(slot + SL_TT + 0 * 512 + lane * 8) = cvt4(aU);
            *(LAS bf16x4*)(slot + SL_TT + 1 * 512 + lane * 8) = cvt4(aKa);
            *(LAS bf16x4*)(slot + SL_TT + 2 * 512 + lane * 8) = cvt4(aBr);
            *(LAS bf16x4*)(slot + SL_TT + 3 * 512 + lane * 8) = cvt4(aKr);
        }
        RAW_BARRIER();
        for (int cc = 0; cc < 4; ++cc) {
            const LAS unsigned char* sl = base + cc * SLOT;
            bf16x8 Af[2], Rf[2], BK[4]; f32x4 wt[4];
#pragma unroll
            for (int m = 0; m < 2; ++m) { const int off = fr * RS + (32 * m + 4 * g) * 2;
                Af[m] = cat8(*(const LAS bf16x4*)(sl + SL_AT + off), *(const LAS bf16x4*)(sl + SL_AT + off + 32));
                Rf[m] = cat8(*(const LAS bf16x4*)(sl + SL_RT + off), *(const LAS bf16x4*)(sl + SL_RT + off + 32)); }
#pragma unroll
            for (int jt = 0; jt < 4; ++jt) { const int off = (16 * jt + fr) * RS2 + 8 * g;
                BK[jt] = cat8(*(const LAS bf16x4*)(sl + SL_BH + off), *(const LAS bf16x4*)(sl + SL_KH + off));
                wt[jt] = *(const LAS f32x4*)(sl + SL_WT + (16 * jt + 4 * g) * 4); }
            const bf16x4 tU = *(const LAS bf16x4*)(sl + SL_TT + 0 * 512 + lane * 8), tKa = *(const LAS bf16x4*)(sl + SL_TT + 1 * 512 + lane * 8);
            const bf16x4 tBr = *(const LAS bf16x4*)(sl + SL_TT + 2 * 512 + lane * 8), tKr = *(const LAS bf16x4*)(sl + SL_TT + 3 * 512 + lane * 8);
            const bf16x4 Vf = *(const LAS bf16x4*)(sl + SL_V + (i0 + fr) * RS2 + 8 * g);
            const bf16x8 B01 = cat8(cvt4(St[0]), cvt4(St[1])), B23 = cat8(cvt4(St[2]), cvt4(St[3]));
            const f32x4 z4 = {0.f, 0.f, 0.f, 0.f};
            f32x4 X = mfma32(Af[0], B01, z4); X = mfma32(Af[1], B23, X); X = mfma16(tKa, Vf, X);
            const f32x4 SA = mfma16(tU, cvt4(X), z4);
            const bf16x8 BSV = cat8(cvt4(SA), Vf);
            f32x4 Yv = mfma32(Rf[0], B01, z4); Yv = mfma32(Rf[1], B23, Yv); Yv = mfma32(cat8(tBr, tKr), BSV, Yv);
#pragma unroll
            for (int jt = 0; jt < 4; ++jt) St[jt] = mfma32(BK[jt], BSV, St[jt] * wt[jt]);
#pragma unroll
            for (int jj = 0; jj < 4; ++jj) *(LAS bf16_t*)(ybuf + (16 * cc + 4 * g + jj) * 144 + (i0 + fr) * 2) = f2bf(Yv[jj]);
        }
        RAW_BARRIER();
#pragma unroll
        for (int q = 0; q < 2; ++q) { const int tl = 16 * ws + (lane >> 3) + 8 * q, tau = 64 * G + tl, t = dir ? (SEQ - 1 - tau) : tau;
            u32x4* yp = (u32x4*)(Y + (size_t)t * RW + (lane & 7) * 8);
            u32x4 w = *(const LAS u32x4*)(ybuf + tl * 144 + (lane & 7) * 16);
            if (G >= SEQ / 128) { const u32x4 o = *yp;
#pragma unroll
                for (int e = 0; e < 4; ++e) w[e] = cvt_pk_bf16(__uint_as_float(w[e] << 16) + __uint_as_float(o[e] << 16), __uint_as_float(w[e] & 0xffff0000u) + __uint_as_float(o[e] & 0xffff0000u)); }
            *yp = w; }
        if (G == SEQ / 128 - 1) { asm volatile("s_waitcnt vmcnt(0)" ::: "memory"); RAW_BARRIER(); }
    }
    RAW_BARRIER();
#undef SCAN_LOAD_RAW
#undef LDU16
}

__device__ __forceinline__ void unpack8(const u32x4 w, float (&f)[8]) {
#pragma unroll
    for (int i = 0; i < 4; ++i) { f[2 * i] = __uint_as_float(w[i] << 16); f[2 * i + 1] = __uint_as_float(w[i] & 0xffff0000u); }
}
__device__ __forceinline__ float sum8lanes(float v) {
    v += __builtin_bit_cast(float, __builtin_amdgcn_update_dpp(0, __builtin_bit_cast(int, v), 0xB1, 0xf, 0xf, true));
    v += __builtin_bit_cast(float, __builtin_amdgcn_update_dpp(0, __builtin_bit_cast(int, v), 0x4E, 0xf, 0xf, true));
    v += __builtin_bit_cast(float, __builtin_amdgcn_update_dpp(0, __builtin_bit_cast(int, v), 0x141, 0xf, 0xf, true));
    return v; }
__device__ __forceinline__ void post_phase(const Ctx& c) {
    if (c.gw >= 2046) return;
    const int third = c.gw % 3, cb = third * 512 + c.lane * 8;
    const bf16_t* proj = (const bf16_t*)(c.a.ws + WS_PROJ);
    const bf16_t* o5 = (const bf16_t*)(c.a.ws + WS_OUT5);
    const bf16_t* yy = (const bf16_t*)((unsigned char*)c.a.out + DO_Y);
    bf16_t* amix = (bf16_t*)(c.a.ws + WS_AMIX);
    float mur[8], muk[8], muv[8], lg[8], lb[8], ka[8], rk[8];
#pragma unroll
    for (int e = 0; e < 8; ++e) { mur[e] = c.a.in[2][R_OFF - 512 + cb + e]; muk[e] = c.a.in[2][K_OFF - 512 + cb + e]; muv[e] = c.a.in[2][V_OFF - 512 + cb + e];
        lg[e] = c.a.in[15][cb + e]; lb[e] = c.a.in[16][cb + e]; ka[e] = c.a.in[13][cb + e]; rk[e] = c.a.in[14][cb + e]; }
    for (int tok = c.gw / 3; tok < NTOK; tok += 682) {
        const int t = tok & (SEQ - 1);
        const float fp = t > 0 ? 1.0f : 0.0f, fn = t < SEQ - 1 ? 1.0f : 0.0f;
        const bf16_t* p0 = proj + (size_t)tok * INP + cb; const bf16_t* pp = t > 0 ? p0 - INP : p0; const bf16_t* pn = t < SEQ - 1 ? p0 + INP : p0;
        const u32x4 wr0 = *(const u32x4*)(p0 + R_OFF), wrp = *(const u32x4*)(pp + R_OFF), wrn = *(const u32x4*)(pn + R_OFF);
        const u32x4 wk0 = *(const u32x4*)(p0 + K_OFF), wkp = *(const u32x4*)(pp + K_OFF), wkn = *(const u32x4*)(pn + K_OFF);
        const u32x4 wv0 = *(const u32x4*)(p0 + V_OFF), wvp = *(const u32x4*)(pp + V_OFF), wvn = *(const u32x4*)(pn + V_OFF);
        const size_t e0 = (size_t)tok * RW + cb;
        const u32x4 wyy = *(const u32x4*)(yy + e0), waf = *(const u32x4*)(o5 + 2 * OUT5_STRIDE + e0), wab = *(const u32x4*)(o5 + 3 * OUT5_STRIDE + e0), wg = *(const u32x4*)(o5 + 4 * OUT5_STRIDE + e0);
        float r[8], k[8], v[8], y[8], x0[8], x1[8], x2[8];
        unpack8(wr0, x0); unpack8(wrp, x1); unpack8(wrn, x2);
#pragma unroll
        for (int e = 0; e < 8; ++e) r[e] = x0[e] + (0.5f * (x1[e] * fp + x2[e] * fn) - x0[e]) * mur[e];
        unpack8(wk0, x0); unpack8(wkp, x1); unpack8(wkn, x2);
#pragma unroll
        for (int e = 0; e < 8; ++e) k[e] = x0[e] + (0.5f * (x1[e] * fp + x2[e] * fn) - x0[e]) * muk[e];
        unpack8(wv0, x0); unpack8(wvp, x1); unpack8(wvn, x2);
#pragma unroll
        for (int e = 0; e < 8; ++e) v[e] = x0[e] + (0.5f * (x1[e] * fp + x2[e] * fn) - x0[e]) * muv[e];
        unpack8(wyy, y);
        float s = 0.f;
#pragma unroll
        for (int e = 0; e < 8; ++e) s += y[e];
        const float m = sum8lanes(s) * (1.0f / 64.0f);
        float s2 = 0.f;
#pragma unroll
        for (int e = 0; e < 8; ++e) { y[e] -= m; s2 += y[e] * y[e]; }
        const float rstd = rsqrtf(sum8lanes(s2) * (1.0f / 64.0f) + GN_EPS);
        unpack8(waf, x0); unpack8(wab, x1); unpack8(wg, x2);
        float bs = 0.f;
#pragma unroll
        for (int e = 0; e < 8; ++e) bs += r[e] * k[e] * (2.0f + (x0[e] + x1[e] - 2.0f) * ka[e]) * rk[e];
        const float bon = sum8lanes(bs);
        float o[8];
#pragma unroll
        for (int e = 0; e < 8; ++e) o[e] = (y[e] * rstd * lg[e] + lb[e] + bon * v[e]) * x2[e];
        u32x4 w; w.x = cvt_pk_bf16(o[0], o[1]); w.y = cvt_pk_bf16(o[2], o[3]); w.z = cvt_pk_bf16(o[4], o[5]); w.w = cvt_pk_bf16(o[6], o[7]);
        *(u32x4*)(amix + (size_t)tok * DM + 512 + cb) = w;
    }
}

__device__ __forceinline__ void ln_phase(const Ctx& c, float* Z, bf16_t* ZB, const float* g, const float* bta, float* O) {
    for (int row0 = c.gw; row0 < NTOK; row0 += 2 * c.NGW) {
        f32x4 v[2][8]; float s[2] = {0.f, 0.f};
#pragma unroll
        for (int u = 0; u < 2; ++u) { const f32x4* zr = (const f32x4*)(Z + (size_t)(row0 + u * c.NGW) * DM) + c.lane;
#pragma unroll
            for (int j = 0; j < 8; ++j) v[u][j] = zr[64 * j]; }
#pragma unroll
        for (int u = 0; u < 2; ++u)
#pragma unroll
            for (int j = 0; j < 8; ++j) s[u] += (v[u][j][0] + v[u][j][1]) + (v[u][j][2] + v[u][j][3]);
        float mean[2], s2[2] = {0.f, 0.f}, rstd[2];
#pragma unroll
        for (int u = 0; u < 2; ++u) mean[u] = wave_sum(s[u]) * (1.0f / DM);
#pragma unroll
        for (int u = 0; u < 2; ++u)
#pragma unroll
            for (int j = 0; j < 8; ++j) { v[u][j] = v[u][j] - mean[u]; s2[u] += (v[u][j][0] * v[u][j][0] + v[u][j][1] * v[u][j][1]) + (v[u][j][2] * v[u][j][2] + v[u][j][3] * v[u][j][3]); }
#pragma unroll
        for (int u = 0; u < 2; ++u) rstd[u] = rsqrtf(wave_sum(s2[u]) * (1.0f / DM) + LN_EPS);
#pragma unroll
        for (int j = 0; j < 8; ++j) { const f32x4 gg = ((const f32x4*)g)[c.lane + 64 * j], bb = ((const f32x4*)bta)[c.lane + 64 * j];
#pragma unroll
            for (int u = 0; u < 2; ++u) { const size_t row = (size_t)(row0 + u * c.NGW);
                const f32x4 o = v[u][j] * rstd[u] * gg + bb;
                if (O) ((f32x4*)(O + row * DM))[c.lane + 64 * j] = o;
                if (ZB) { u32x2 w; w.x = cvt_pk_bf16(o[0], o[1]); w.y = cvt_pk_bf16(o[2], o[3]); ((u32x2*)(ZB + row * DM))[c.lane + 64 * j] = w; } } }
    }
}


#define XB_TMO      128
#define XB_XCNT(j)  (256  + 64 * (j))
#define XB_XSUB(j)  (1280 + 64 * (j))
#define XB_XGEN(j)  (2304 + 64 * (j))
#define XB_TOP      3328
#define XB_TOPGEN   3392
#define XCD_BAR_WORDS 3456
#define XB_SPIN_CAP (1u << 18)
__device__ __forceinline__ unsigned xb_ld(unsigned* p)              { return __hip_atomic_load(p, __ATOMIC_RELAXED, __HIP_MEMORY_SCOPE_AGENT); }
__device__ __forceinline__ unsigned xb_add(unsigned* p, unsigned v) { return __hip_atomic_fetch_add(p, v, __ATOMIC_RELAXED, __HIP_MEMORY_SCOPE_AGENT); }
__device__ __forceinline__ unsigned xb_xcc_id() { return (unsigned)__builtin_amdgcn_s_getreg((3 << 11) | 20) & 0xFu; }
#define XB_SPIN(cond, bar) do { unsigned _sp = 0; while (cond) { __builtin_amdgcn_s_sleep(1); \
    if ((++_sp & 255u) == 0u) { if (xb_ld(&(bar)[XB_TMO])) break; if (_sp > XB_SPIN_CAP) { atomicAdd(&(bar)[XB_TMO], 1u); break; } } } } while (0)
struct XcdBarrier { unsigned* bar; unsigned x; volatile LAS unsigned* st; };
__device__ __forceinline__ XcdBarrier xcd_barrier_post(unsigned* bar, volatile LAS unsigned* st) {
    XcdBarrier b; b.bar = bar; b.x = xb_xcc_id(); b.st = st;
    if (threadIdx.x == 0) (void)xb_add(&bar[XB_XCNT(b.x)], 1u);
    return b;
}
__device__ __forceinline__ void xcd_barrier_complete(unsigned* bar, unsigned x, unsigned& nloc, unsigned& nx) {
    const unsigned G = gridDim.x * gridDim.y * gridDim.z;
    unsigned sum, cnt, mine, sp = 0u;
    for (;;) {
        sum = 0u; cnt = 0u; mine = 0u;
#pragma unroll
        for (unsigned j = 0; j < 16; ++j) { const unsigned c = xb_ld(&bar[XB_XCNT(j)]); sum += c; cnt += (c > 0u) ? 1u : 0u; mine = (j == x) ? c : mine; }
        if (sum == G) break;
        __builtin_amdgcn_s_sleep(1);
        if ((++sp & 255u) == 0u) { if (xb_ld(&bar[XB_TMO])) break; if (sp > XB_SPIN_CAP) { atomicAdd(&bar[XB_TMO], 1u); break; } }
    }
    nloc = mine > 0u ? mine : 1u; nx = cnt > 0u ? cnt : 1u;
}
__device__ __forceinline__ void xcd_barrier(const XcdBarrier& b) {
    asm volatile("s_waitcnt vmcnt(0)" ::: "memory");
    __syncthreads();
    if (threadIdx.x == 0) {
        unsigned* bar = b.bar;
        __builtin_amdgcn_s_waitcnt(0);
        unsigned nloc = b.st[0], nx = b.st[1];
        if (nloc == 0u) { xcd_barrier_complete(bar, b.x, nloc, nx); b.st[0] = nloc; b.st[1] = nx; }
        const unsigned old = xb_add(&bar[XB_XSUB(b.x)], 1u);
        const unsigned gen = old / nloc;
        if (old + 1u == (gen + 1u) * nloc) {
            __builtin_amdgcn_fence(__ATOMIC_RELEASE, "agent");
            asm volatile("s_waitcnt vmcnt(0)" ::: "memory");
            const unsigned og = xb_add(&bar[XB_TOP], 1u);
            const unsigned tg = og / nx;
            if (og + 1u == (tg + 1u) * nx) xb_add(&bar[XB_TOPGEN], 1u);
            else XB_SPIN(xb_ld(&bar[XB_TOPGEN]) == tg, bar);
            __builtin_amdgcn_fence(__ATOMIC_ACQUIRE, "agent");
            xb_add(&bar[XB_XGEN(b.x)], 1u);
            asm volatile("s_waitcnt vmcnt(0)" ::: "memory");
        } else {
            XB_SPIN(xb_ld(&bar[XB_XGEN(b.x)]) == gen, bar);
            __builtin_amdgcn_fence(__ATOMIC_ACQUIRE, "agent");
            asm volatile("s_waitcnt vmcnt(0)" ::: "memory");
        }
    }
    __syncthreads();
}

template <bool OUT_F32> __device__ __forceinline__ void ln_bf16_phase(const Ctx& c, const bf16_t* Z, void* Ov, const float* g, const float* bta) {
    for (int row0 = c.gw; row0 < NTOK; row0 += 2 * c.NGW) {
        float v[2][32]; float s[2] = {0.f, 0.f};
#pragma unroll
        for (int u = 0; u < 2; ++u) { const u32x4* zr = (const u32x4*)(Z + (size_t)(row0 + u * c.NGW) * DM) + c.lane;
#pragma unroll
            for (int j = 0; j < 4; ++j) { const u32x4 w = zr[64 * j];
#pragma unroll
                for (int e = 0; e < 4; ++e) { v[u][8 * j + 2 * e] = __uint_as_float(w[e] << 16); v[u][8 * j + 2 * e + 1] = __uint_as_float(w[e] & 0xffff0000u); } } }
#pragma unroll
        for (int u = 0; u < 2; ++u)
#pragma unroll
            for (int e = 0; e < 32; ++e) s[u] += v[u][e];
        float mean[2], s2[2] = {0.f, 0.f}, rstd[2];
#pragma unroll
        for (int u = 0; u < 2; ++u) mean[u] = wave_sum_dpp(s[u]) * (1.0f / DM);
#pragma unroll
        for (int u = 0; u < 2; ++u)
#pragma unroll
            for (int e = 0; e < 32; ++e) { v[u][e] -= mean[u]; s2[u] += v[u][e] * v[u][e]; }
#pragma unroll
        for (int u = 0; u < 2; ++u) rstd[u] = rsqrtf(wave_sum_dpp(s2[u]) * (1.0f / DM) + LN_EPS);
#pragma unroll
        for (int j = 0; j < 4; ++j) { const f32x4 g0 = ((const f32x4*)g)[2 * (c.lane + 64 * j)], g1 = ((const f32x4*)g)[2 * (c.lane + 64 * j) + 1];
            const f32x4 b0 = ((const f32x4*)bta)[2 * (c.lane + 64 * j)], b1 = ((const f32x4*)bta)[2 * (c.lane + 64 * j) + 1];
#pragma unroll
            for (int u = 0; u < 2; ++u) { float o[8];
#pragma unroll
                for (int e = 0; e < 4; ++e) { o[e] = v[u][8 * j + e] * rstd[u] * g0[e] + b0[e]; o[4 + e] = v[u][8 * j + 4 + e] * rstd[u] * g1[e] + b1[e]; }
                if (OUT_F32) { f32x4* op = (f32x4*)((float*)Ov + (size_t)(row0 + u * c.NGW) * DM) + 2 * (c.lane + 64 * j);
                    op[0] = (f32x4){o[0], o[1], o[2], o[3]}; op[1] = (f32x4){o[4], o[5], o[6], o[7]}; }
                else { u32x4 w; w.x = cvt_pk_bf16(o[0], o[1]); w.y = cvt_pk_bf16(o[2], o[3]); w.z = cvt_pk_bf16(o[4], o[5]); w.w = cvt_pk_bf16(o[6], o[7]);
                    ((u32x4*)((bf16_t*)Ov + (size_t)(row0 + u * c.NGW) * DM))[c.lane + 64 * j] = w; } } }
    }
}

constexpr int N_PHASES = 11;
constexpr int LDS_BYTES = 8 * SLOT + 2 * YBUF;

#ifndef PROBE_REP_PHASE
#define PROBE_REP_PHASE -1
#endif
#define PHASE(n) if (a.ph_lo <= (n) && (n) < a.ph_hi) for (int rep_ = 0; rep_ < ((n) == PROBE_REP_PHASE ? 2 : 1); ++rep_)
#define SEAM(n) do { if (a.ph_lo < (n) && (n) < a.ph_hi) xcd_barrier(xb); __syncthreads(); } while (0)
__global__ void __launch_bounds__(512, 2) fwd_megakernel(Args a) {
    extern __shared__ __attribute__((aligned(16))) unsigned char smem[];
    LAS unsigned char* lds = (LAS unsigned char*)smem;
    const int G = gridDim.x, bid = blockIdx.x;
    __shared__ uint4 xb_words;
    if (threadIdx.x == 0) xb_words = make_uint4(0u, 0u, 0u, 0u);
    __syncthreads();
    XcdBarrier xb; xb.bar = (unsigned*)(a.ws + WS_BAR); xb.x = 0; xb.st = (volatile LAS unsigned*)&xb_words;
    if (a.ph_hi - a.ph_lo > 1) xb = xcd_barrier_post((unsigned*)(a.ws + WS_BAR), (volatile LAS unsigned*)&xb_words);
    if (a.ph_hi > 1000) cg::this_grid().sync();
    PHASE(0) { Ctx c(a, lds); phase0(c); }
    SEAM(1);
    PHASE(1) {
        pg8::Order<0> S; S.init(NTOK, INP, G, bid, a.ws + WS_XB, DM, a.ws + WS_WINT, DM);
        pg8::EpiBf16 E{(bf16_t*)(a.ws + WS_PROJ), INP};
        pg8::gemm_phase(lds, DM, DM, DM, S, E);
        __syncthreads();
        if (G == 256 && bid >= 128) phase1_fill(a, lds, bid - 128, 128);
        else if (G != 256) phase1_fill(a, lds, bid, G); }
    SEAM(2);
    PHASE(2) { Ctx c(a, lds); phase2(c); }
    SEAM(3);
    PHASE(3) {
        pg8::Order<3> S; S.init(NTOK, 6144, G, bid, (unsigned char*)a.out + DO_ALORA, 512, a.ws + WS_WLT, 128);
        pg8::EpiLora E{(bf16_t*)(a.ws + WS_OUT5), (const float*)(a.ws + WS_BIAS), 0};
        pg8::gemm_phase(lds, 128, 512, 128, S, E); }
    __syncthreads();
    PHASE(3) {
        pg8::Order<0> S; S.init(NTOK, 1536, G, bid, (unsigned char*)a.out + DO_ALORA + 512, 512, a.ws + WS_WLT + 2 * MiB, 256);
        pg8::EpiLora E{(bf16_t*)(a.ws + WS_OUT5), (const float*)(a.ws + WS_BIAS), 4};
        pg8::gemm_phase(lds, 256, 512, 256, S, E); }
    __syncthreads();
    PHASE(3) {
        pg8::Order<0> S; S.init(1024, NTOK, G, bid, a.ws + WS_CDFT, 512, a.ws + WS_PROJ, INP);
        pg8::EpiCdft E{(bf16_t*)((unsigned char*)a.out + DO_FABT)};
        pg8::gemm_phase(lds, 512, 512, INP, S, E); }
    SEAM(4);
    PHASE(4) {
        if (bid >= 192) {
            pg8::Order<2> S; S.init(NTOK, 512, 64, bid - 192, a.ws + WS_DFTM, 4096, (unsigned char*)a.out + DO_FABT, 4096);
            pg8::EpiBf16 E{(bf16_t*)(a.ws + WS_AMIX), DM};
            pg8::gemm_phase(lds, 4096, 4096, 4096, S, E);
            __syncthreads();
            {
                const int lane = threadIdx.x & 63, wave = __builtin_amdgcn_readfirstlane(threadIdx.x >> 6);
                LAS float* scr = (LAS float*)(lds + wave * 16384);
                for (int it = (bid - 192) * 8 + wave; it < 88 * 64; it += 64 * 8) tr_item<0>(a.in[22], DFF, DM, (bf16_t*)((unsigned char*)a.out + DO_WDNT), DFF, scr, it, lane); }
        } else scan2_phase(a, lds); }
    SEAM(5);
    PHASE(5) { Ctx c(a, lds); post_phase(c); }
    SEAM(6);
    PHASE(6) {
        pg8::Order<0> S; S.init(NTOK, DM, G, bid, a.ws + WS_AMIX, DM, a.ws + WS_WOUTT, DM);
        pg8::EpiResToBf16 E{(bf16_t*)(a.ws + WS_H), a.in[0]};
        pg8::gemm_phase(lds, DM, DM, DM, S, E); }
    SEAM(7);
    PHASE(7) {
        Ctx c(a, lds);
        ln_bf16_phase<false>(c, (const bf16_t*)(a.ws + WS_H), a.ws + WS_HB, a.in[18], a.in[19]);
        LAS float* scr = (LAS float*)(lds + c.wave * 16384);
        for (int it = c.gw; it < 32 * 176; it += c.NGW) tr_item<1>(a.in[20], DM, DFF, (bf16_t*)(a.ws + WS_WGUT), DM, scr, it, c.lane);
        for (int it = c.gw; it < 32 * 176; it += c.NGW) tr_item<2>(a.in[21], DM, DFF, (bf16_t*)(a.ws + WS_WGUT), DM, scr, it, c.lane);
    }
    SEAM(8);
    PHASE(8) {
        pg8::Order<0> S; S.init(NTOK, 2 * DFF, G, bid, a.ws + WS_HB, DM, a.ws + WS_WGUT, DM);
        pg8::EpiSwiglu E{(bf16_t*)(a.ws + WS_FFA)};
        pg8::gemm_phase(lds, DM, DM, DM, S, E); }
    SEAM(9);
    PHASE(9) {
        pg8::Order<0> S; S.init(NTOK, DM, G, bid, a.ws + WS_FFA, DFF, (unsigned char*)a.out + DO_WDNT, DFF);
        pg8::EpiResBfToBf E{(bf16_t*)(a.ws + WS_H), (const bf16_t*)(a.ws + WS_HB)};
        pg8::gemm_phase(lds, DFF, DFF, DFF, S, E); }
    SEAM(10);
    PHASE(10) { Ctx c(a, lds); ln_bf16_phase<true>(c, (const bf16_t*)(a.ws + WS_H), a.out, a.in[23], a.in[24]); }
}

extern "C" void kernel_launch(void* const* d_in, const int* in_sizes, int n_in, void* d_out, int out_size, void* d_ws, size_t ws_size, hipStream_t stream) {
    static int grid = 0;
    if (grid == 0) {
        if (n_in != 25 || out_size != NTOK * DM || ws_size < WS_END) { fprintf(stderr, "kernel_launch: unexpected shapes (n_in %d out %d ws %zu need %zu)\n", n_in, out_size, ws_size, (size_t)WS_END); grid = -1; return; }
        int dev = 0, cus = 0, per_cu = 0;
        hipGetDevice(&dev); hipDeviceGetAttribute(&cus, hipDeviceAttributeMultiprocessorCount, dev);
        if (hipFuncSetAttribute((const void*)fwd_megakernel, hipFuncAttributeMaxDynamicSharedMemorySize, LDS_BYTES) != hipSuccess) { fprintf(stderr, "kernel_launch: hipFuncSetAttribute failed\n"); grid = -1; return; }
        hipOccupancyMaxActiveBlocksPerMultiprocessor(&per_cu, (const void*)fwd_megakernel, 512, LDS_BYTES);
        if (per_cu < 1) { fprintf(stderr, "kernel_launch: occupancy query says %d blocks per CU\n", per_cu); (void)hipGetLastError(); per_cu = 1; }
        grid = cus < 256 ? cus : 256;
    }
    if (grid < 0) return;
    Args a{};
    for (int i = 0; i < 25; ++i) a.in[i] = (const float*)d_in[i];
    a.out = (float*)d_out; a.ws = (unsigned char*)d_ws;
#if N_LAUNCH_MODE == 1
    if (hipMemsetAsync((unsigned char*)d_ws + WS_BAR, 0, XCD_BAR_WORDS * 4, stream) != hipSuccess) { fprintf(stderr, "kernel_launch: memset of the barrier words failed\n"); return; }
    a.ph_lo = 0; a.ph_hi = N_PHASES;
    void* args[] = {&a};
    hipError_t e = hipLaunchCooperativeKernel((const void*)fwd_megakernel, dim3(grid), dim3(512), args, LDS_BYTES, stream);
    if (e != hipSuccess) fprintf(stderr, "cooperative launch failed: %s (grid %d)\n", hipGetErrorString(e), grid);
#else
    for (int ph = 0; ph < N_PHASES; ++ph) { a.ph_lo = ph; a.ph_hi = ph + 1;
        hipLaunchKernelGGL(fwd_megakernel, dim3(grid), dim3(512), LDS_BYTES, stream, a); }
#endif
}
```

```cpp
#include <hip/hip_runtime.h>
#include <hip/hip_cooperative_groups.h>
#include <cstdio>
#include <cstdint>
namespace cg = cooperative_groups;

#ifndef N_LAUNCH_MODE
#define N_LAUNCH_MODE 1
#endif

#define LAS __attribute__((address_space(3)))
typedef unsigned short bf16_t;
typedef short bf16x8 __attribute__((ext_vector_type(8)));
typedef float f32x4 __attribute__((ext_vector_type(4)));
typedef float f32x2 __attribute__((ext_vector_type(2)));
typedef unsigned u32x4 __attribute__((ext_vector_type(4)));
typedef unsigned u32x2 __attribute__((ext_vector_type(2)));

constexpr int NTOK = 16384, DM = 2048, SEQ = 2048, NB = 8;
constexpr int INP = 5632;
constexpr int RW = 1536, NH = 24;
constexpr int R_OFF = 512, K_OFF = 2048, V_OFF = 3584, G_OFF = 5120;
constexpr int DFF = 5632;
constexpr float ALPHA = 1.189207115002721f;
constexpr float LN_EPS = 1e-5f, GN_EPS = 64e-5f;

constexpr size_t MiB = 1048576;
constexpr size_t WS_RA    = 0;
constexpr size_t WS_XB    = WS_RA;
constexpr size_t WS_WINT  = 88 * MiB + 176 * MiB;
constexpr size_t WS_AMIX  = WS_RA;
constexpr size_t WS_DFTM  = WS_RA + 64 * MiB;
constexpr size_t WS_WOUTT = WS_RA + 80 * MiB;
constexpr size_t WS_WGUT  = WS_RA;
constexpr size_t WS_PROJ  = 88 * MiB;
constexpr size_t WS_FFA   = WS_PROJ;
constexpr size_t WS_OUT5  = WS_PROJ + 176 * MiB;
constexpr size_t WS_H     = WS_OUT5;
constexpr size_t WS_HB    = WS_OUT5 + 128 * MiB;
constexpr size_t WS_SMALL = WS_OUT5 + 240 * MiB;
constexpr size_t WS_WLT   = WS_SMALL;
constexpr size_t WS_CDFT  = WS_SMALL + 4 * MiB;
constexpr size_t WS_BIAS  = WS_SMALL + 5 * MiB;
constexpr size_t WS_BAR   = WS_BIAS + 65536;
constexpr size_t WS_END   = WS_SMALL + 6 * MiB;
constexpr size_t DO_Y = 0, DO_WDNT = 48 * MiB, DO_FABT = 96 * MiB, DO_ALORA = 0;
constexpr size_t OUT5_STRIDE = (size_t)NTOK * RW;

struct Args {
    const float* in[25];
    float* out;
    unsigned char* ws;
    int ph_lo, ph_hi;
};

typedef __bf16 bf16v2 __attribute__((ext_vector_type(2)));
__device__ __forceinline__ unsigned cvt_pk_bf16(float lo, float hi) { const f32x2 v = {lo, hi}; return __builtin_bit_cast(unsigned, __builtin_convertvector(v, bf16v2)); }
__device__ __forceinline__ float bf2f(bf16_t h) { return __uint_as_float(((unsigned)h) << 16); }
__device__ __forceinline__ bf16_t f2bf(float f) { return (bf16_t)(cvt_pk_bf16(f, 0.f) & 0xffffu); }
__device__ __forceinline__ float wave_sum(float v) {
#pragma unroll
    for (int o = 1; o < 64; o <<= 1) v += __shfl_xor(v, o);
    return v;
}
__device__ __forceinline__ float wave_sum_dpp(float v) {
    v += __builtin_bit_cast(float, __builtin_amdgcn_update_dpp(0, __builtin_bit_cast(int, v), 0xB1, 0xf, 0xf, true));
    v += __builtin_bit_cast(float, __builtin_amdgcn_update_dpp(0, __builtin_bit_cast(int, v), 0x4E, 0xf, 0xf, true));
    v += __builtin_bit_cast(float, __builtin_amdgcn_update_dpp(0, __builtin_bit_cast(int, v), 0x141, 0xf, 0xf, true));
    v += __builtin_bit_cast(float, __builtin_amdgcn_update_dpp(0, __builtin_bit_cast(int, v), 0x140, 0xf, 0xf, true));
    v += __builtin_bit_cast(float, __builtin_amdgcn_update_dpp(0, __builtin_bit_cast(int, v), 0x142, 0xa, 0xf, false));
    v += __builtin_bit_cast(float, __builtin_amdgcn_update_dpp(0, __builtin_bit_cast(int, v), 0x143, 0xc, 0xf, false));
    return __builtin_bit_cast(float, __builtin_amdgcn_readlane(__builtin_bit_cast(int, v), 63));
}
__device__ __forceinline__ float sigmoidf_(float z) { return __builtin_amdgcn_rcpf(1.0f + __expf(-z)); }
#define LDS_WAIT() asm volatile("s_waitcnt lgkmcnt(0)" ::: "memory")
#define RAW_BARRIER() do { asm volatile("s_waitcnt lgkmcnt(0)" ::: "memory"); __builtin_amdgcn_s_barrier(); asm volatile("" ::: "memory"); } while (0)
constexpr int INP_ = 5632, SEQ_ = 2048;
__device__ __forceinline__ float shifted(const bf16_t* p, int t, float mu) {
    const float fp = t > 0 ? 1.0f : 0.0f, fn = t < SEQ_ - 1 ? 1.0f : 0.0f;
    const bf16_t* q0 = t > 0 ? p - INP_ : p; const bf16_t* q1 = t < SEQ_ - 1 ? p + INP_ : p;
    const float p0 = bf2f(p[0]), pp = bf2f(q0[0]) * fp, pn = bf2f(q1[0]) * fn;
    return p0 + (0.5f * (pp + pn) - p0) * mu;
}


namespace pg8 {
constexpr int BM = 256, BK = 64, HALF = 128, HTB = HALF * BK * 2, STAGE_BYTES = 8 * HTB, NXCD = 8, WGM = 8;
__host__ __device__ __forceinline__ int lds_byte(int r, int c) { const int st = (r >> 4) * 2 + (c >> 5), rr = r & 15, cc = c & 31, ob = rr * 64 + cc * 2; return st * 1024 + (ob ^ (((ob >> 9) & 1) << 5)); }
__host__ __device__ __forceinline__ void stage_rc(int b, int& R, int& C) { const int st = b / 1024, sb = b % 1024, swz = sb ^ (((sb >> 9) & 1) << 5); R = (st >> 1) * 16 + swz / 64; C = (st & 1) * 32 + (swz % 64) / 2; }
__host__ __device__ __forceinline__ int perm32(int rho) { const int n = rho >> 4, i = rho & 15; return 8 * (i >> 2) + 4 * n + (i & 3); }
struct Unit { int pm, pn; };

template <int MODE> struct Order {
    int nM, nN, nwg, G, c;
    const char* A; const char* B; size_t tA, tB;
    __device__ void init(int M, int N, int G_, int c_, const void* A_, int lda, const void* B_, int ldb) {
        nM = M / BM; nN = N / BM; nwg = nM * nN; G = G_; c = c_; A = (const char*)A_; B = (const char*)B_; tA = (size_t)BM * lda * 2; tB = (size_t)BM * ldb * 2; }
    __device__ bool next(int i, Unit& u) const {
        const long L = (long)i * G + c; if (L >= nwg) return false;
        int wgid = (int)L; { const int q = nwg / NXCD, r = nwg % NXCD, xcd = wgid % NXCD, off = wgid / NXCD; wgid = (xcd < r ? xcd * (q + 1) : r * (q + 1) + (xcd - r) * q) + off; }
        const int nig = WGM * nN, gid = wgid / nig, fm = gid * WGM, gsz = (nM - fm) < WGM ? (nM - fm) : WGM;
        u.pm = fm + ((wgid % nig) % gsz); u.pn = (wgid % nig) / gsz; return true;
    }
    __device__ __forceinline__ const char* pa(const Unit& u) const {
        if (MODE == 1) return A + (size_t)u.pm * tA + (u.pn >= 24 ? 512 : 0);
        if (MODE == 3) return A + (size_t)u.pm * tA + (u.pn >= 12 ? 256 : 0);
        if (MODE == 2) return A + (size_t)(u.pm & 7) * tA;
        return A + (size_t)u.pm * tA; }
    __device__ __forceinline__ const char* pb(const Unit& u) const {
        if (MODE == 2) return B + (size_t)(u.pm >> 3) * ((size_t)512 * 4096 * 2) + (size_t)u.pn * tB;
        return B + (size_t)u.pn * tB; }
};

struct EpiBf16 {
    static constexpr bool PERM = true;
    bf16_t* O; int ldc;
    __device__ __forceinline__ void operator()(const f32x4 (&acc)[2][2][4][2], const Unit& u, int wr, int wc, int fr, int fq) const {
        const int row0 = u.pm * BM + wr * 64 + fr, col0 = u.pn * BM + wc * 32 + 8 * fq;
#pragma unroll
        for (int ai = 0; ai < 2; ++ai)
#pragma unroll
            for (int m = 0; m < 4; ++m) { bf16_t* rowp = O + (size_t)(row0 + ai * HALF + m * 16) * ldc + col0;
#pragma unroll
                for (int bj = 0; bj < 2; ++bj) { const f32x4 v0 = acc[ai][bj][m][0], v1 = acc[ai][bj][m][1];
                    u32x4 w; w.x = cvt_pk_bf16(v0[0], v0[1]); w.y = cvt_pk_bf16(v0[2], v0[3]); w.z = cvt_pk_bf16(v1[0], v1[1]); w.w = cvt_pk_bf16(v1[2], v1[3]);
                    *(u32x4*)(rowp + bj * HALF) = w; } }
    }
};
struct EpiLora {
    static constexpr bool PERM = true;
    bf16_t* O; const float* bias; int qoff;
    __device__ __forceinline__ void operator()(const f32x4 (&acc)[2][2][4][2], const Unit& u, int wr, int wc, int fr, int fq) const {
        const int q = u.pn / 6 + qoff, cb = (u.pn % 6) * BM + wc * 32 + 8 * fq;
        const int row0 = u.pm * BM + wr * 64 + fr;
        bf16_t* base = O + (size_t)q * OUT5_STRIDE + cb;
        const float* bp = bias + (q & 3) * RW + cb;
        const float sc = (q < 2) ? -0.6065306597126334f : 1.0f;
#pragma unroll
        for (int ai = 0; ai < 2; ++ai)
#pragma unroll
            for (int m = 0; m < 4; ++m) { bf16_t* rowp = base + (size_t)(row0 + ai * HALF + m * 16) * RW;
#pragma unroll
                for (int bj = 0; bj < 2; ++bj) { f32x4 v0 = acc[ai][bj][m][0], v1 = acc[ai][bj][m][1];
                    if (q < 4) { const f32x4 c0 = *(const f32x4*)(bp + bj * HALF), c1 = *(const f32x4*)(bp + bj * HALF + 4);
#pragma unroll
                        for (int j = 0; j < 4; ++j) { v0[j] = sc * sigmoidf_(v0[j] + c0[j]); v1[j] = sc * sigmoidf_(v1[j] + c1[j]); } }
                    u32x4 w; w.x = cvt_pk_bf16(v0[0], v0[1]); w.y = cvt_pk_bf16(v0[2], v0[3]); w.z = cvt_pk_bf16(v1[0], v1[1]); w.w = cvt_pk_bf16(v1[2], v1[3]);
                    *(u32x4*)(rowp + bj * HALF) = w; }
                asm volatile("" ::: "memory"); }
    }
};
struct EpiCdft {
    static constexpr bool PERM = true;
    bf16_t* O;
    __device__ __forceinline__ void operator()(const f32x4 (&acc)[2][2][4][2], const Unit& u, int wr, int wc, int fr, int fq) const {
        const int row0 = u.pm * BM + wr * 64 + fr, tok0 = u.pn * BM + wc * 32 + 8 * fq;
        const int b = tok0 >> 11, pos0 = tok0 & 2047;
#pragma unroll
        for (int ai = 0; ai < 2; ++ai)
#pragma unroll
            for (int m = 0; m < 4; ++m) { const int mm = row0 + ai * HALF + m * 16, part = mm >> 9, np = mm & 511;
                bf16_t* rowp = O + ((size_t)(b * 512 + np) * 4096 + part * 2048 + pos0);
#pragma unroll
                for (int bj = 0; bj < 2; ++bj) { const f32x4 v0 = acc[ai][bj][m][0], v1 = acc[ai][bj][m][1];
                    u32x4 w; w.x = cvt_pk_bf16(v0[0], v0[1]); w.y = cvt_pk_bf16(v0[2], v0[3]); w.z = cvt_pk_bf16(v1[0], v1[1]); w.w = cvt_pk_bf16(v1[2], v1[3]);
                    *(u32x4*)(rowp + bj * HALF) = w; } }
    }
};
struct EpiResF32 {
    static constexpr bool PERM = false;
    float* C; const float* res;
    __device__ __forceinline__ void operator()(const f32x4 (&acc)[2][2][4][2], const Unit& u, int wr, int wc, int fr, int fq) const {
        const int row0 = u.pm * BM + wr * 64 + fr, col0 = u.pn * BM + wc * 32 + 4 * fq;
#pragma unroll
        for (int ai = 0; ai < 2; ++ai)
#pragma unroll
            for (int m = 0; m < 4; ++m) { const size_t off = (size_t)(row0 + ai * HALF + m * 16) * DM + col0;
#pragma unroll
                for (int bj = 0; bj < 2; ++bj)
#pragma unroll
                    for (int n = 0; n < 2; ++n) { const f32x4 rs = *(const f32x4*)(res + off + bj * HALF + n * 16); *(f32x4*)(C + off + bj * HALF + n * 16) = acc[ai][bj][m][n] + ALPHA * rs; }
                asm volatile("" ::: "memory"); }
    }
};
struct EpiResToBf16 {
    static constexpr bool PERM = true;
    bf16_t* O; const float* res;
    __device__ __forceinline__ void operator()(const f32x4 (&acc)[2][2][4][2], const Unit& u, int wr, int wc, int fr, int fq) const {
        const int row0 = u.pm * BM + wr * 64 + fr, col0 = u.pn * BM + wc * 32 + 8 * fq;
#pragma unroll
        for (int ai = 0; ai < 2; ++ai)
#pragma unroll
            for (int m = 0; m < 4; ++m) { const size_t off = (size_t)(row0 + ai * HALF + m * 16) * DM + col0;
#pragma unroll
                for (int bj = 0; bj < 2; ++bj) { const f32x4 r0 = __builtin_nontemporal_load((const f32x4*)(res + off + bj * HALF)), r1 = __builtin_nontemporal_load((const f32x4*)(res + off + bj * HALF + 4));
                    const f32x4 v0 = acc[ai][bj][m][0] + ALPHA * r0, v1 = acc[ai][bj][m][1] + ALPHA * r1;
                    u32x4 w; w.x = cvt_pk_bf16(v0[0], v0[1]); w.y = cvt_pk_bf16(v0[2], v0[3]); w.z = cvt_pk_bf16(v1[0], v1[1]); w.w = cvt_pk_bf16(v1[2], v1[3]);
                    *(u32x4*)(O + off + bj * HALF) = w; }
                asm volatile("" ::: "memory"); }
    }
};
struct EpiResBfToBf {
    static constexpr bool PERM = true;
    bf16_t* O; const bf16_t* res;
    __device__ __forceinline__ void operator()(const f32x4 (&acc)[2][2][4][2], const Unit& u, int wr, int wc, int fr, int fq) const {
        const int row0 = u.pm * BM + wr * 64 + fr, col0 = u.pn * BM + wc * 32 + 8 * fq;
#pragma unroll
        for (int ai = 0; ai < 2; ++ai)
#pragma unroll
            for (int m = 0; m < 4; ++m) { const size_t off = (size_t)(row0 + ai * HALF + m * 16) * DM + col0;
#pragma unroll
                for (int bj = 0; bj < 2; ++bj) { const u32x4 rb = __builtin_nontemporal_load((const u32x4*)(res + off + bj * HALF));
                    const f32x4 r0 = {__uint_as_float(rb.x << 16), __uint_as_float(rb.x & 0xffff0000u), __uint_as_float(rb.y << 16), __uint_as_float(rb.y & 0xffff0000u)};
                    const f32x4 r1 = {__uint_as_float(rb.z << 16), __uint_as_float(rb.z & 0xffff0000u), __uint_as_float(rb.w << 16), __uint_as_float(rb.w & 0xffff0000u)};
                    const f32x4 v0 = acc[ai][bj][m][0] + ALPHA * r0, v1 = acc[ai][bj][m][1] + ALPHA * r1;
                    u32x4 w; w.x = cvt_pk_bf16(v0[0], v0[1]); w.y = cvt_pk_bf16(v0[2], v0[3]); w.z = cvt_pk_bf16(v1[0], v1[1]); w.w = cvt_pk_bf16(v1[2], v1[3]);
                    *(u32x4*)(O + off + bj * HALF) = w; }
                asm volatile("" ::: "memory"); }
    }
};
struct EpiResBf16 {
    static constexpr bool PERM = false;
    float* C; const bf16_t* res;
    __device__ __forceinline__ void operator()(const f32x4 (&acc)[2][2][4][2], const Unit& u, int wr, int wc, int fr, int fq) const {
        const int row0 = u.pm * BM + wr * 64 + fr, col0 = u.pn * BM + wc * 32 + 4 * fq;
#pragma unroll
        for (int ai = 0; ai < 2; ++ai)
#pragma unroll
            for (int m = 0; m < 4; ++m) { const size_t off = (size_t)(row0 + ai * HALF + m * 16) * DM + col0;
#pragma unroll
                for (int bj = 0; bj < 2; ++bj)
#pragma unroll
                    for (int n = 0; n < 2; ++n) { const u32x2 rb = *(const u32x2*)(res + off + bj * HALF + n * 16);
                        const f32x4 rs = {__uint_as_float(rb.x << 16), __uint_as_float(rb.x & 0xffff0000u), __uint_as_float(rb.y << 16), __uint_as_float(rb.y & 0xffff0000u)};
                        *(f32x4*)(C + off + bj * HALF + n * 16) = acc[ai][bj][m][n] + ALPHA * rs; }
                asm volatile("" ::: "memory"); }
    }
};
struct EpiSwiglu {
    static constexpr bool PERM = true;
    bf16_t* O;
    __device__ __forceinline__ void operator()(const f32x4 (&acc)[2][2][4][2], const Unit& u, int wr, int wc, int fr, int fq) const {
        const int row0 = u.pm * BM + wr * 64 + fr, col0 = u.pn * HALF + wc * 32 + 8 * fq;
#pragma unroll
        for (int ai = 0; ai < 2; ++ai)
#pragma unroll
            for (int m = 0; m < 4; ++m) { bf16_t* rowp = O + (size_t)(row0 + ai * HALF + m * 16) * DFF + col0;
                f32x4 o0, o1;
#pragma unroll
                for (int j = 0; j < 4; ++j) { const float g0 = acc[ai][0][m][0][j], g1 = acc[ai][0][m][1][j];
                    o0[j] = g0 * sigmoidf_(g0) * acc[ai][1][m][0][j]; o1[j] = g1 * sigmoidf_(g1) * acc[ai][1][m][1][j]; }
                u32x4 w; w.x = cvt_pk_bf16(o0[0], o0[1]); w.y = cvt_pk_bf16(o0[2], o0[3]); w.z = cvt_pk_bf16(o1[0], o1[1]); w.w = cvt_pk_bf16(o1[2], o1[3]);
                *(u32x4*)rowp = w; }
    }
};

template <class Epi, class Sched>
__device__ __forceinline__ void gemm_phase(LAS unsigned char* lds, const int K, const int lda, const int ldb, const Sched& S, const Epi& E) {
    const int tid = threadIdx.x, wid = __builtin_amdgcn_readfirstlane(tid >> 6), lane = tid & 63, wr = wid >> 2, wc = wid & 3, fr = lane & 15, fq = lane >> 4;
    const int nt = K / BK;
    unsigned voffA[2], voffB[2];
#pragma unroll
    for (int i = 0; i < 2; ++i) { int R, C; stage_rc(tid * 16 + i * 8192, R, C); const int Rb = Epi::PERM ? ((R & ~31) + perm32(R & 31)) : R;
        voffA[i] = (unsigned)(R * lda + C) * 2u; voffB[i] = (unsigned)(Rb * ldb + C) * 2u; }
    const size_t kstep = (size_t)(BK * 2);
    const size_t hstepA = (size_t)HALF * lda * 2, hstepB = (size_t)HALF * ldb * 2;
    const unsigned ldsw = (unsigned)wid * 1024u;
    const int aoff = lds_byte(wr * 64 + fr, fq * 8), boff = lds_byte(wc * 32 + fr, fq * 8);
#define PG8_SA(b, h) (((b) * 2 + (h)) * HTB)
#define PG8_SB(b, h) ((4 + (b) * 2 + (h)) * HTB)
#define PG8_STAGE(bufoff, gbase, voff) do { _Pragma("unroll") for (int _i = 0; _i < 2; ++_i) \
        __builtin_amdgcn_global_load_lds((const unsigned*)((const char*)(gbase) + (voff)[_i]), (LAS unsigned*)(lds + (bufoff) + ldsw + _i * 8192), 16, 0, 0); } while (0)
#define PG8_LDA(dst, b, h) do { _Pragma("unroll") for (int m = 0; m < 4; ++m) _Pragma("unroll") for (int k = 0; k < 2; ++k) dst[m][k] = *(const LAS bf16x8*)(lds + PG8_SA(b, h) + aoff + m * 2048 + k * 1024); } while (0)
#define PG8_LDB(dst, b, h) do { _Pragma("unroll") for (int n = 0; n < 2; ++n) _Pragma("unroll") for (int k = 0; k < 2; ++k) dst[n][k] = *(const LAS bf16x8*)(lds + PG8_SB(b, h) + boff + n * 2048 + k * 1024); } while (0)
#define PG8_MMA(ai, bj, At, Bt) do { __builtin_amdgcn_s_setprio(1); _Pragma("unroll") for (int m = 0; m < 4; ++m) _Pragma("unroll") for (int n = 0; n < 2; ++n) _Pragma("unroll") for (int k = 0; k < 2; ++k) \
        acc[ai][bj][m][n] = __builtin_amdgcn_mfma_f32_16x16x32_bf16(Bt[n][k], At[m][k], acc[ai][bj][m][n], 0, 0, 0); __builtin_amdgcn_s_setprio(0); } while (0)
#define PG8_WAIT_V(n) asm volatile("s_waitcnt vmcnt(" #n ")" ::: "memory")
#define PG8_WAIT_L(n) asm volatile("s_waitcnt lgkmcnt(" #n ")" ::: "memory")
#define PG8_BAR __builtin_amdgcn_s_barrier()
#define PG8_SCHED __builtin_amdgcn_sched_barrier(0)
    Unit cur, nxt; int ui = 0;
    if (!S.next(0, cur)) return;
    f32x4 acc[2][2][4][2];
#pragma unroll
    for (int a = 0; a < 2; ++a)
#pragma unroll
        for (int b = 0; b < 2; ++b)
#pragma unroll
            for (int m = 0; m < 4; ++m)
#pragma unroll
                for (int n = 0; n < 2; ++n) acc[a][b][m][n] = (f32x4){0.f, 0.f, 0.f, 0.f};
    bf16x8 At[4][2], B0[2][2], B1[2][2];
    const char* cA = S.pa(cur); const char* cB = S.pb(cur);
    PG8_STAGE(PG8_SB(0, 0), cB, voffB); PG8_STAGE(PG8_SB(0, 1), cB + hstepB, voffB); PG8_STAGE(PG8_SA(0, 0), cA, voffA); PG8_STAGE(PG8_SA(0, 1), cA + hstepA, voffA);
    if (wr == 1) PG8_BAR;
    PG8_WAIT_V(2); PG8_BAR;
    PG8_STAGE(PG8_SB(1, 0), cB + kstep, voffB); PG8_STAGE(PG8_SA(1, 0), cA + kstep, voffA); PG8_STAGE(PG8_SB(1, 1), cB + hstepB + kstep, voffB);
    PG8_WAIT_V(6); PG8_BAR;
    for (;;) {
        const bool has_next = S.next(ui + 1, nxt);
        const char* nA = has_next ? S.pa(nxt) : cA; const char* nB = has_next ? S.pb(nxt) : cB;
        for (int t = 0; t < nt; t += 2) {
            const bool last = (t == nt - 2);
            const char* a1 = cA + (size_t)(t + 1) * kstep;
            const char* a2 = last ? nA : cA + (size_t)(t + 2) * kstep; const char* b2 = last ? nB : cB + (size_t)(t + 2) * kstep;
            const char* a3 = a2 + kstep; const char* b3 = b2 + kstep;
            PG8_LDB(B0, 0, 0); PG8_LDB(B1, 0, 1); PG8_SCHED; PG8_LDA(At, 0, 0); PG8_STAGE(PG8_SA(1, 1), a1 + hstepA, voffA);
            PG8_WAIT_V(8); PG8_WAIT_L(0); PG8_BAR; PG8_MMA(0, 0, At, B0); PG8_MMA(0, 1, At, B1); PG8_BAR; PG8_SCHED;
            PG8_LDA(At, 0, 1); PG8_STAGE(PG8_SB(0, 0), b2, voffB); PG8_STAGE(PG8_SB(0, 1), b2 + hstepB, voffB); PG8_STAGE(PG8_SA(0, 0), a2, voffA);
            PG8_WAIT_V(8); PG8_WAIT_L(0); PG8_BAR; PG8_MMA(1, 0, At, B0); PG8_MMA(1, 1, At, B1); PG8_BAR; PG8_SCHED;
            PG8_LDB(B0, 1, 0); PG8_LDB(B1, 1, 1); PG8_SCHED; PG8_LDA(At, 1, 0); PG8_STAGE(PG8_SA(0, 1), a2 + hstepA, voffA);
            PG8_WAIT_V(8); PG8_WAIT_L(0); PG8_BAR; PG8_MMA(0, 0, At, B0); PG8_MMA(0, 1, At, B1); PG8_BAR; PG8_SCHED;
            PG8_LDA(At, 1, 1); PG8_STAGE(PG8_SB(1, 0), b3, voffB); PG8_STAGE(PG8_SB(1, 1), b3 + hstepB, voffB); PG8_STAGE(PG8_SA(1, 0), a3, voffA);
            PG8_WAIT_V(8); PG8_WAIT_L(0); PG8_BAR; PG8_MMA(1, 0, At, B0); PG8_MMA(1, 1, At, B1); PG8_BAR; PG8_SCHED;
        }
        if (wr == 0) PG8_BAR;
        E(acc, cur, wr, wc, fr, fq);
        if (!has_next) break;
#pragma unroll
        for (int a = 0; a < 2; ++a)
#pragma unroll
            for (int b = 0; b < 2; ++b)
#pragma unroll
                for (int m = 0; m < 4; ++m)
#pragma unroll
                    for (int n = 0; n < 2; ++n) acc[a][b][m][n] = (f32x4){0.f, 0.f, 0.f, 0.f};
        cur = nxt; cA = nA; cB = nB; ++ui;
        if (wr == 1) PG8_BAR;
    }
    PG8_WAIT_V(0);
    PG8_BAR;
#undef PG8_SA
#undef PG8_SB
#undef PG8_STAGE
#undef PG8_LDA
#undef PG8_LDB
#undef PG8_MMA
#undef PG8_WAIT_V
#undef PG8_WAIT_L
#undef PG8_BAR
#undef PG8_SCHED
}
}

template <int MODE> __device__ __forceinline__ void tr_item(const float* W, int K, int N, bf16_t* WT, int ldd, LAS float* scr, int item, int lane) {
    const int nblk = N / 32, kb = item / nblk, nb = item % nblk, k0 = 64 * kb, n0 = 32 * nb;
    float tv[32];
#pragma unroll
    for (int i = 0; i < 32; ++i) tv[i] = __builtin_nontemporal_load(W + (size_t)(k0 + 2 * i + (lane >> 5)) * N + n0 + (lane & 31));
#pragma unroll
    for (int i = 0; i < 32; ++i) scr[(2 * i + (lane >> 5)) * 33 + (lane & 31)] = tv[i];
    LDS_WAIT();
    const int c = lane & 7;
#pragma unroll
    for (int j = 0; j < 4; ++j) { const int n = n0 + (lane >> 3) + 8 * j; const LAS float* s = scr + (8 * c) * 33 + (n - n0);
        u32x4 o; o.x = cvt_pk_bf16(s[0 * 33], s[1 * 33]); o.y = cvt_pk_bf16(s[2 * 33], s[3 * 33]); o.z = cvt_pk_bf16(s[4 * 33], s[5 * 33]); o.w = cvt_pk_bf16(s[6 * 33], s[7 * 33]);
        const int dr = (MODE == 0) ? n : (256 * (n >> 7) + (MODE == 2 ? 128 : 0) + (n & 127));
        *(u32x4*)(WT + (size_t)dr * ldd + k0 + 8 * c) = o; }
    LDS_WAIT();
}

struct Ctx {
    const Args& a; LAS unsigned char* lds; int lane, wave, bid, G, gw, NGW, gtid, GT;
    __device__ __forceinline__ Ctx(const Args& a_, LAS unsigned char* l) : a(a_), lds(l), lane(threadIdx.x & 63), wave(__builtin_amdgcn_readfirstlane(threadIdx.x >> 6)), bid(blockIdx.x), G(gridDim.x),
        gw(blockIdx.x * 8 + wave), NGW(gridDim.x * 8), gtid(blockIdx.x * 512 + threadIdx.x), GT(gridDim.x * 512) {}
};

__device__ __forceinline__ void phase0(const Ctx& c) {
    const float* x = c.a.in[0];
    bf16_t* xb = (bf16_t*)(c.a.ws + WS_XB);
    for (size_t i0 = c.gtid; i0 < (size_t)NTOK * DM / 8; i0 += (size_t)4 * c.GT) {
        f32x4 p[4], q[4];
#pragma unroll
        for (int u = 0; u < 4; ++u) { const size_t i = i0 + (size_t)u * c.GT; p[u] = __builtin_nontemporal_load((const f32x4*)x + 2 * i); q[u] = __builtin_nontemporal_load((const f32x4*)x + 2 * i + 1); }
#pragma unroll
        for (int u = 0; u < 4; ++u) { const size_t i = i0 + (size_t)u * c.GT;
            u32x4 o; o.x = cvt_pk_bf16(p[u][0], p[u][1]); o.y = cvt_pk_bf16(p[u][2], p[u][3]); o.z = cvt_pk_bf16(q[u][0], q[u][1]); o.w = cvt_pk_bf16(q[u][2], q[u][3]); ((u32x4*)xb)[i] = o; } }
    LAS float* scr = (LAS float*)(c.lds + c.wave * 16384);
    bf16_t* wint = (bf16_t*)(c.a.ws + WS_WINT);
    for (int it = c.gw; it < 32 * 175; it += c.NGW) tr_item<0>(c.a.in[1], DM, 5600, wint, DM, scr, it, c.lane);
    for (int i = c.gtid; i < 32 * DM / 8; i += c.GT) ((u32x4*)(wint + (size_t)5600 * DM))[i] = (u32x4){0u, 0u, 0u, 0u};
}

__device__ __forceinline__ void phase2(const Ctx& c) {
    const bf16_t* proj = (const bf16_t*)(c.a.ws + WS_PROJ);
    bf16_t* al = (bf16_t*)((unsigned char*)c.a.out + DO_ALORA);
    const float* mu = c.a.in[2];
    for (int i = c.gtid; i < NTOK * 64; i += c.GT) { const int tok = i >> 6, g = i & 63, t = tok & (SEQ - 1);
        u32x4 w = {0u, 0u, 0u, 0u};
        if (g < 60) { const int col = (g < 32) ? (5344 + 8 * g) : (G_OFF + 8 * (g - 32));
            const bf16_t* p0 = proj + (size_t)tok * INP + col; const bf16_t* pp = t > 0 ? p0 - INP : p0; const bf16_t* pn = t < SEQ - 1 ? p0 + INP : p0;
            const float fp = t > 0 ? 1.0f : 0.0f, fn = t < SEQ - 1 ? 1.0f : 0.0f;
            float x0[8], x1[8], x2[8], o[8];
            { const u32x4 w0 = *(const u32x4*)p0, w1 = *(const u32x4*)pp, w2 = *(const u32x4*)pn;
#pragma unroll
              for (int e = 0; e < 4; ++e) { x0[2 * e] = __uint_as_float(w0[e] << 16); x0[2 * e + 1] = __uint_as_float(w0[e] & 0xffff0000u); x1[2 * e] = __uint_as_float(w1[e] << 16); x1[2 * e + 1] = __uint_as_float(w1[e] & 0xffff0000u);
                  x2[2 * e] = __uint_as_float(w2[e] << 16); x2[2 * e + 1] = __uint_as_float(w2[e] & 0xffff0000u); } }
            const f32x4 m0 = *(const f32x4*)(mu + col - 512), m1 = *(const f32x4*)(mu + col - 512 + 4);
#pragma unroll
            for (int e = 0; e < 8; ++e) { const float s = x0[e] + (0.5f * (x1[e] * fp + x2[e] * fn) - x0[e]) * (e < 4 ? m0[e] : m1[e - 4]);
                o[e] = (g < 16) ? (1.0f - 2.0f * __builtin_amdgcn_rcpf(1.0f + __expf(2.0f * s))) : (g < 32) ? s : sigmoidf_(s); }
            w.x = cvt_pk_bf16(o[0], o[1]); w.y = cvt_pk_bf16(o[2], o[3]); w.z = cvt_pk_bf16(o[4], o[5]); w.w = cvt_pk_bf16(o[6], o[7]); }
        ((u32x4*)al)[i] = w; }
}
__device__ __forceinline__ void phase1_fill(const Args& a, LAS unsigned char* lds, int idx, int n) {
    const int lane = threadIdx.x & 63, wave = __builtin_amdgcn_readfirstlane(threadIdx.x >> 6), gtid = idx * 512 + threadIdx.x, GT = n * 512, gw = idx * 8 + wave, NGW = n * 8;
    LAS float* T = (LAS float*)(lds + 131072);
    for (int m = threadIdx.x; m < 2048; m += 512) T[m] = cospif((float)m * (1.0f / 1024.0f)) * 0.022097086912079608f;
    __syncthreads();
    bf16_t* dm = (bf16_t*)(a.ws + WS_DFTM);
    for (int i = gtid; i < 2048 * 4096 / 8; i += GT) { const int sp = i >> 9, k0 = (i & 511) * 8; float v[8];
#pragma unroll
        for (int j = 0; j < 8; ++j) { const int k = k0 + j; v[j] = T[(sp * (k & 2047) + (k < 2048 ? 0 : 512)) & 2047]; }
        u32x4 o; o.x = cvt_pk_bf16(v[0], v[1]); o.y = cvt_pk_bf16(v[2], v[3]); o.z = cvt_pk_bf16(v[4], v[5]); o.w = cvt_pk_bf16(v[6], v[7]); ((u32x4*)dm)[i] = o; }
    __syncthreads();
    bf16_t* wlt = (bf16_t*)(a.ws + WS_WLT);
    for (int i = gtid; i < 6144 * 128; i += GT) { const int n = i >> 7, k = i & 127, q = n / RW, ch = n % RW; float v = 0.f;
        if ((k >> 6) == (q & 1)) { const float* up = (q == 0) ? a.in[3] : (q == 1) ? a.in[4] : (q == 2) ? a.in[7] : a.in[8]; v = up[(size_t)(k & 63) * RW + ch]; }
        wlt[i] = f2bf(v); }
    bf16_t* wgt = (bf16_t*)(a.ws + WS_WLT + 2 * MiB);
    for (int i = gtid; i < 1536 * 256; i += GT) { const int ch = i >> 8, k = i & 255; wgt[i] = f2bf(k < 224 ? a.in[11][(size_t)k * RW + ch] : 0.f); }
    { float* bs = (float*)(a.ws + WS_BIAS);
      for (int i = gtid; i < RW; i += GT) { bs[i] = a.in[5][i]; bs[RW + i] = a.in[6][i]; bs[2 * RW + i] = a.in[9][i]; bs[3 * RW + i] = a.in[10][i]; } }
    bf16_t* cd = (bf16_t*)(a.ws + WS_CDFT);
    for (int i = gtid; i < 1024 * 512; i += GT) { const int m = i >> 9, k = i & 511, part = m >> 9, g = (m >> 7) & 3, cp = m & 127, g2 = k >> 7, cc = k & 127; float v = 0.f;
        if (g == g2) { const float ang = (float)((cc * cp) & 127) * (1.0f / 64.0f); v = (part ? sinpif(ang) : cospif(ang)) * 0.08838834764831845f; }
        cd[i] = f2bf(v); }
    LAS float* scr = (LAS float*)(lds + wave * 16384);
    for (int it = gw; it < 32 * 64; it += NGW) tr_item<0>(a.in[17], DM, DM, (bf16_t*)(a.ws + WS_WOUTT), DM, scr, it, lane);
}

typedef short bf16x4 __attribute__((ext_vector_type(4)));
constexpr int YBUF = 64 * 144;
constexpr int RS = 136, RS2 = 40;
constexpr int SL_AT = 0, SL_RT = 2176, SL_BT = 4352, SL_TT = 4352, SL_KT = 6528, SL_BH = 8704, SL_KH = 11264, SL_V = 13824, SL_WT = 16384, SLOT = 16640;
__device__ __forceinline__ bf16x4 cvt4(const f32x4 v) { u32x2 w; w.x = cvt_pk_bf16(v[0], v[1]); w.y = cvt_pk_bf16(v[2], v[3]); return __builtin_bit_cast(bf16x4, w); }
__device__ __forceinline__ bf16x8 cat8(const bf16x4 lo, const bf16x4 hi) { return __builtin_shufflevector(lo, hi, 0, 1, 2, 3, 4, 5, 6, 7); }
__device__ __forceinline__ f32x4 mfma16(const bf16x4 a, const bf16x4 b, const f32x4 c) { return __builtin_amdgcn_mfma_f32_16x16x16bf16_1k(a, b, c, 0, 0, 0); }
__device__ __forceinline__ f32x4 mfma32(const bf16x8 a, const bf16x8 b, const f32x4 c) { return __builtin_amdgcn_mfma_f32_16x16x32_bf16(a, b, c, 0, 0, 0); }

__device__ __forceinline__ void scan2_phase(const Args& a, LAS unsigned char* lds) {
    const int bid = blockIdx.x; if (bid >= 192) return;
    const int lane = threadIdx.x & 63, wave = __builtin_amdgcn_readfirstlane(threadIdx.x >> 6), dir = wave >> 2, ws = wave & 3;
    const int b = bid / NH, h = bid % NH, ch = h * 64 + lane, fr = lane & 15, g = lane >> 4, i0 = 16 * ws;
    LAS unsigned char* base = lds + dir * (4 * SLOT);
    const float kk_ = a.in[12][ch], ka_ = a.in[13][ch];
    const float mur = a.in[2][R_OFF - 512 + ch], muk = a.in[2][K_OFF - 512 + ch], muv = a.in[2][V_OFF - 512 + ch];
    const unsigned char* P = a.ws + WS_PROJ + (size_t)b * SEQ * INP * 2;
    const unsigned char* LW = a.ws + WS_OUT5 + ((size_t)dir * OUT5_STRIDE + (size_t)b * SEQ * RW) * 2;
    const unsigned char* AI = a.ws + WS_OUT5 + ((size_t)(2 + dir) * OUT5_STRIDE + (size_t)b * SEQ * RW) * 2;
    const unsigned voK = (unsigned)(K_OFF + ch) * 2u, voC = (unsigned)ch * 2u;
    const long sP = dir ? -(long)(INP * 2) : (long)(INP * 2), sL = dir ? -(long)(RW * 2) : (long)(RW * 2);
    bf16_t* Y = (bf16_t*)((unsigned char*)a.out + DO_Y) + (size_t)b * SEQ * RW + h * 64;
    LAS unsigned char* ybuf = lds + 8 * SLOT + dir * YBUF;
    f32x4 St[4];
#pragma unroll
    for (int jt = 0; jt < 4; ++jt) St[jt] = (f32x4){0.f, 0.f, 0.f, 0.f};
    unsigned rru[18], kru[18], vru[18], lwu[16], aiu[16];
#define LDU16(base, boff) ((unsigned)(*(const bf16_t*)((base) + (boff))))
#define SCAN_LOAD_RAW(cidx) do { \
        const int t0_ = dir ? (SEQ - 16 * (cidx)) : (16 * (cidx) - 1), l0_ = dir ? (SEQ - 1 - 16 * (cidx)) : (16 * (cidx)); \
        const unsigned char* bP_ = P + (long)t0_ * (INP * 2); const unsigned char* bL_ = LW + (long)l0_ * (RW * 2); const unsigned char* bA_ = AI + (long)l0_ * (RW * 2); \
        _Pragma("unroll") for (int i = 0; i < 18; ++i) { const unsigned char* rb = bP_ + sP * i; \
            rru[i] = LDU16(rb, voK - (K_OFF - R_OFF) * 2); kru[i] = LDU16(rb, voK); vru[i] = LDU16(rb, voK + (V_OFF - K_OFF) * 2); } \
        _Pragma("unroll") for (int i = 0; i < 16; ++i) { lwu[i] = LDU16(bL_ + sL * i, voC); aiu[i] = LDU16(bA_ + sL * i, voC); } } while (0)
    SCAN_LOAD_RAW(ws);
    for (int G = 0; G < SEQ / 64; ++G) {
        LAS unsigned char* slot = base + ws * SLOT;
        {
            float rr[18], kr[18], vr[18], lwv[16], aiv[16];
            { const int cidx = 4 * G + ws;
#pragma unroll
              for (int i = 0; i < 18; ++i) { const unsigned m = (i == 0) ? ((cidx == 0) ? 0u : 0xffffffffu) : (i == 17) ? ((cidx == SEQ / 16 - 1) ? 0u : 0xffffffffu) : 0xffffffffu;
                  rr[i] = __uint_as_float((rru[i] << 16) & m); kr[i] = __uint_as_float((kru[i] << 16) & m); vr[i] = __uint_as_float((vru[i] << 16) & m); }
#pragma unroll
              for (int i = 0; i < 16; ++i) { lwv[i] = __uint_as_float(lwu[i] << 16); aiv[i] = __uint_as_float(aiu[i] << 16); } }
            float E[17], Ei[16]; E[0] = 1.0f;
            { float Lc = 0.f;
#pragma unroll
              for (int tt = 0; tt < 16; ++tt) { Lc += lwv[tt] * 1.4426950408889634f; E[tt + 1] = __builtin_amdgcn_exp2f(Lc); Ei[tt] = __builtin_amdgcn_exp2f(-Lc); } }
            const float ET = E[16];
            float bh[16], kh[16], vv[16];
#pragma unroll
            for (int tp = 0; tp < 16; tp += 2) {
                float av[2], bv[2], kv[2], rv[2];
#pragma unroll
                for (int u = 0; u < 2; ++u) { const int tt = tp + u;
                    const float r = rr[tt + 1] + (0.5f * (rr[tt] + rr[tt + 2]) - rr[tt + 1]) * mur;
                    const float k = kr[tt + 1] + (0.5f * (kr[tt] + kr[tt + 2]) - kr[tt + 1]) * muk;
                    const float v = vr[tt + 1] + (0.5f * (vr[tt] + vr[tt + 2]) - vr[tt + 1]) * muv;
                    const float ai = aiv[tt];
                    const float kkr = k * kk_; const float n2 = wave_sum_dpp(kkr * kkr);
                    const float kk = kkr * rsqrtf(fmaxf(n2, 1e-24f));
                    const float kd = k * (1.0f + (ai - 1.0f) * ka_);
                    const float bt = kk * ai * Ei[tt], kt = kd * Ei[tt];
                    av[u] = -kk * E[tt]; bv[u] = bt; kv[u] = kt; rv[u] = r * E[tt + 1];
                    bh[tt] = bt * ET; kh[tt] = kt * ET; vv[tt] = v; }
                const unsigned wa = cvt_pk_bf16(av[0], av[1]), wb = cvt_pk_bf16(bv[0], bv[1]), wk = cvt_pk_bf16(kv[0], kv[1]), wr_ = cvt_pk_bf16(rv[0], rv[1]);
                *(LAS bf16_t*)(slot + SL_AT + tp * RS + lane * 2) = (bf16_t)(wa & 0xffffu); *(LAS bf16_t*)(slot + SL_AT + (tp + 1) * RS + lane * 2) = (bf16_t)(wa >> 16);
                *(LAS bf16_t*)(slot + SL_BT + tp * RS + lane * 2) = (bf16_t)(wb & 0xffffu); *(LAS bf16_t*)(slot + SL_BT + (tp + 1) * RS + lane * 2) = (bf16_t)(wb >> 16);
                *(LAS bf16_t*)(slot + SL_KT + tp * RS + lane * 2) = (bf16_t)(wk & 0xffffu); *(LAS bf16_t*)(slot + SL_KT + (tp + 1) * RS + lane * 2) = (bf16_t)(wk >> 16);
                *(LAS bf16_t*)(slot + SL_RT + tp * RS + lane * 2) = (bf16_t)(wr_ & 0xffffu); *(LAS bf16_t*)(slot + SL_RT + (tp + 1) * RS + lane * 2) = (bf16_t)(wr_ >> 16);
            }
#pragma unroll
            for (int q = 0; q < 4; ++q) { u32x2 w0, w1, w2;
                w0.x = cvt_pk_bf16(bh[4 * q + 0], bh[4 * q + 1]); w0.y = cvt_pk_bf16(bh[4 * q + 2], bh[4 * q + 3]);
                w1.x = cvt_pk_bf16(kh[4 * q + 0], kh[4 * q + 1]); w1.y = cvt_pk_bf16(kh[4 * q + 2], kh[4 * q + 3]);
                w2.x = cvt_pk_bf16(vv[4 * q + 0], vv[4 * q + 1]); w2.y = cvt_pk_bf16(vv[4 * q + 2], vv[4 * q + 3]);
                *(LAS u32x2*)(slot + SL_BH + lane * RS2 + q * 8) = w0; *(LAS u32x2*)(slot + SL_KH + lane * RS2 + q * 8) = w1; *(LAS u32x2*)(slot + SL_V + lane * RS2 + q * 8) = w2; }
            *(LAS float*)(slot + SL_WT + lane * 4) = ET;
        }
        if (G + 1 < SEQ / 64) SCAN_LOAD_RAW(4 * (G + 1) + ws);
        LDS_WAIT(); __builtin_amdgcn_wave_barrier();
        {
            bf16x8 fa[2], fb[2], fk[2], frr[2];
#pragma unroll
            for (int m = 0; m < 2; ++m) { const int off = fr * RS + (32 * m + 8 * g) * 2;
                fa[m] = cat8(*(const LAS bf16x4*)(slot + SL_AT + off), *(const LAS bf16x4*)(slot + SL_AT + off + 8)); fb[m] = cat8(*(const LAS bf16x4*)(slot + SL_BT + off), *(const LAS bf16x4*)(slot + SL_BT + off + 8));
                fk[m] = cat8(*(const LAS bf16x4*)(slot + SL_KT + off), *(const LAS bf16x4*)(slot + SL_KT + off + 8)); frr[m] = cat8(*(const LAS bf16x4*)(slot + SL_RT + off), *(const LAS bf16x4*)(slot + SL_RT + off + 8)); }
            const f32x4 z4 = {0.f, 0.f, 0.f, 0.f};
            f32x4 aP = mfma32(fa[1], fb[1], mfma32(fa[0], fb[0], z4));
            f32x4 aPT = mfma32(fb[1], fa[1], mfma32(fb[0], fa[0], z4));
            f32x4 aKa = mfma32(fk[1], fa[1], mfma32(fk[0], fa[0], z4));
            f32x4 aBr = mfma32(fb[1], frr[1], mfma32(fb[0], frr[0], z4));
            f32x4 aKr = mfma32(fk[1], frr[1], mfma32(fk[0], frr[0], z4));
            f32x4 aU;
#pragma unroll
            for (int jj = 0; jj < 4; ++jj) { const int rw = 4 * g + jj;
                aP[jj] = (fr < rw) ? aP[jj] : 0.f; aPT[jj] = (rw < fr) ? aPT[jj] : 0.f; aKa[jj] = (rw < fr) ? aKa[jj] : 0.f;
                aBr[jj] = (rw <= fr) ? aBr[jj] : 0.f; aKr[jj] = (rw <= fr) ? aKr[jj] : 0.f; aU[jj] = aPT[jj] + ((rw == fr) ? 1.0f : 0.f); }
            const bf16x4 pP = cvt4(aP), pPT = cvt4(aPT);
            const f32x4 aP2 = mfma16(pPT, pP, z4), aPT2 = mfma16(pP, pPT, z4);
            const bf16x4 pP2 = cvt4(aP2), pPT2 = cvt4(aPT2);
            aU = mfma16(pP2, cvt4(aU), aU);
            const f32x4 aP4 = mfma16(pPT2, pP2, z4), aPT4 = mfma16(pP2, pPT2, z4);
            const bf16x4 pP4 = cvt4(aP4), pPT4 = cvt4(aPT4);
            aU = mfma16(pP4, cvt4(aU), aU);
            const f32x4 aP8 = mfma16(pPT4, pP4, z4);
            aU = mfma16(cvt4(aP8), cvt4(aU), aU);
            *(LAS bf16x4*)(slot + SL_TT + 0 * 512 + lane * 8) = cvt4(aU);
            *(LAS bf16x4*)(slot + SL_TT + 1 * 512 + lane * 8) = cvt4(aKa);
            *(LAS bf16x4*)(slot + SL_TT + 2 * 512 + lane * 8) = cvt4(aBr);
            *(LAS bf16x4*)(slot + SL_TT + 3 * 512 + lane * 8) = cvt4(aKr);
        }
        RAW_BARRIER();
        for (int cc = 0; cc < 4; ++cc) {
            const LAS unsigned char* sl = base + cc * SLOT;
            bf16x8 Af[2], Rf[2], BK[4]; f32x4 wt[4];
#pragma unroll
            for (int m = 0; m < 2; ++m) { const int off = fr * RS + (32 * m + 4 * g) * 2;
                Af[m] = cat8(*(const LAS bf16x4*)(sl + SL_AT + off), *(const LAS bf16x4*)(sl + SL_AT + off + 32));
                Rf[m] = cat8(*(const LAS bf16x4*)(sl + SL_RT + off), *(const LAS bf16x4*)(sl + SL_RT + off + 32)); }
#pragma unroll
            for (int jt = 0; jt < 4; ++jt) { const int off = (16 * jt + fr) * RS2 + 8 * g;
                BK[jt] = cat8(*(const LAS bf16x4*)(sl + SL_BH + off), *(const LAS bf16x4*)(sl + SL_KH + off));
                wt[jt] = *(const LAS f32x4*)(sl + SL_WT + (16 * jt + 4 * g) * 4); }
            const bf16x4 tU = *(const LAS bf16x4*)(sl + SL_TT + 0 * 512 + lane * 8), tKa = *(const LAS bf16x4*)(sl + SL_TT + 1 * 512 + lane * 8);
            const bf16x4 tBr = *(const LAS bf16x4*)(sl + SL_TT + 2 * 512 + lane * 8), tKr = *(const LAS bf16x4*)(sl + SL_TT + 3 * 512 + lane * 8);
            const bf16x4 Vf = *(const LAS bf16x4*)(sl + SL_V + (i0 + fr) * RS2 + 8 * g);
            const bf16x8 B01 = cat8(cvt4(St[0]), cvt4(St[1])), B23 = cat8(cvt4(St[2]), cvt4(St[3]));
            const f32x4 z4 = {0.f, 0.f, 0.f, 0.f};
            f32x4 X = mfma32(Af[0], B01, z4); X = mfma32(Af[1], B23, X); X = mfma16(tKa, Vf, X);
            const f32x4 SA = mfma16(tU, cvt4(X), z4);
            const bf16x8 BSV = cat8(cvt4(SA), Vf);
            f32x4 Yv = mfma32(Rf[0], B01, z4); Yv = mfma32(Rf[1], B23, Yv); Yv = mfma32(cat8(tBr, tKr), BSV, Yv);
#pragma unroll
            for (int jt = 0; jt < 4; ++jt) St[jt] = mfma32(BK[jt], BSV, St[jt] * wt[jt]);
#pragma unroll
            for (int jj = 0; jj < 4; ++jj) *(LAS bf16_t*)(ybuf + (16 * cc + 4 * g + jj) * 144 + (i0 + fr) * 2) = f2bf(Yv[jj]);
        }
        RAW_BARRIER();
#pragma unroll
        for (int q = 0; q < 2; ++q) { const int tl = 16 * ws + (lane >> 3) + 8 * q, tau = 64 * G + tl, t = dir ? (SEQ - 1 - tau) : tau;
            u32x4* yp = (u32x4*)(Y + (size_t)t * RW + (lane & 7) * 8);
            u32x4 w = *(const LAS u32x4*)(ybuf + tl * 144 + (lane & 7) * 16);
            if (G >= SEQ / 128) { const u32x4 o = *yp;
#pragma unroll
                for (int e = 0; e < 4; ++e) w[e] = cvt_pk_bf16(__uint_as_float(w[e] << 16) + __uint_as_float(o[e] << 16), __uint_as_float(w[e] & 0xffff0000u) + __uint_as_float(o[e] & 0xffff0000u)); }
            *yp = w; }
        if (G == SEQ / 128 - 1) { asm volatile("s_waitcnt vmcnt(0)" ::: "memory"); RAW_BARRIER(); }
    }
    RAW_BARRIER();
#undef SCAN_LOAD_RAW
#undef LDU16
}

__device__ __forceinline__ void unpack8(const u32x4 w, float (&f)[8]) {
#pragma unroll
    for (int i = 0; i < 4; ++i) { f[2 * i] = __uint_as_float(w[i] << 16); f[2 * i + 1] = __uint_as_float(w[i] & 0xffff0000u); }
}
__device__ __forceinline__ float sum8lanes(float v) {
    v += __builtin_bit_cast(float, __builtin_amdgcn_update_dpp(0, __builtin_bit_cast(int, v), 0xB1, 0xf, 0xf, true));
    v += __builtin_bit_cast(float, __builtin_amdgcn_update_dpp(0, __builtin_bit_cast(int, v), 0x4E, 0xf, 0xf, true));
    v += __builtin_bit_cast(float, __builtin_amdgcn_update_dpp(0, __builtin_bit_cast(int, v), 0x141, 0xf, 0xf, true));
    return v; }
__device__ __forceinline__ void post_phase(const Ctx& c) {
    if (c.gw >= 2046) return;
    const int third = c.gw % 3, cb = third * 512 + c.lane * 8;
    const bf16_t* proj = (const bf16_t*)(c.a.ws + WS_PROJ);
    const bf16_t* o5 = (const bf16_t*)(c.a.ws + WS_OUT5);
    const bf16_t* yy = (const bf16_t*)((unsigned char*)c.a.out + DO_Y);
    bf16_t* amix = (bf16_t*)(c.a.ws + WS_AMIX);
    float mur[8], muk[8], muv[8], lg[8], lb[8], ka[8], rk[8];
#pragma unroll
    for (int e = 0; e < 8; ++e) { mur[e] = c.a.in[2][R_OFF - 512 + cb + e]; muk[e] = c.a.in[2][K_OFF - 512 + cb + e]; muv[e] = c.a.in[2][V_OFF - 512 + cb + e];
        lg[e] = c.a.in[15][cb + e]; lb[e] = c.a.in[16][cb + e]; ka[e] = c.a.in[13][cb + e]; rk[e] = c.a.in[14][cb + e]; }
    for (int tok = c.gw / 3; tok < NTOK; tok += 682) {
        const int t = tok & (SEQ - 1);
        const float fp = t > 0 ? 1.0f : 0.0f, fn = t < SEQ - 1 ? 1.0f : 0.0f;
        const bf16_t* p0 = proj + (size_t)tok * INP + cb; const bf16_t* pp = t > 0 ? p0 - INP : p0; const bf16_t* pn = t < SEQ - 1 ? p0 + INP : p0;
        const u32x4 wr0 = *(const u32x4*)(p0 + R_OFF), wrp = *(const u32x4*)(pp + R_OFF), wrn = *(const u32x4*)(pn + R_OFF);
        const u32x4 wk0 = *(const u32x4*)(p0 + K_OFF), wkp = *(const u32x4*)(pp + K_OFF), wkn = *(const u32x4*)(pn + K_OFF);
        const u32x4 wv0 = *(const u32x4*)(p0 + V_OFF), wvp = *(const u32x4*)(pp + V_OFF), wvn = *(const u32x4*)(pn + V_OFF);
        const size_t e0 = (size_t)tok * RW + cb;
        const u32x4 wyy = __builtin_nontemporal_load((const u32x4*)(yy + e0)), waf = __builtin_nontemporal_load((const u32x4*)(o5 + 2 * OUT5_STRIDE + e0)), wab = __builtin_nontemporal_load((const u32x4*)(o5 + 3 * OUT5_STRIDE + e0)), wg = __builtin_nontemporal_load((const u32x4*)(o5 + 4 * OUT5_STRIDE + e0));
        float r[8], k[8], v[8], y[8], x0[8], x1[8], x2[8];
        unpack8(wr0, x0); unpack8(wrp, x1); unpack8(wrn, x2);
#pragma unroll
        for (int e = 0; e < 8; ++e) r[e] = x0[e] + (0.5f * (x1[e] * fp + x2[e] * fn) - x0[e]) * mur[e];
        unpack8(wk0, x0); unpack8(wkp, x1); unpack8(wkn, x2);
#pragma unroll
        for (int e = 0; e < 8; ++e) k[e] = x0[e] + (0.5f * (x1[e] * fp + x2[e] * fn) - x0[e]) * muk[e];
        unpack8(wv0, x0); unpack8(wvp, x1); unpack8(wvn, x2);
#pragma unroll
        for (int e = 0; e < 8; ++e) v[e] = x0[e] + (0.5f * (x1[e] * fp + x2[e] * fn) - x0[e]) * muv[e];
        unpack8(wyy, y);
        float s = 0.f;
#pragma unroll
        for (int e = 0; e < 8; ++e) s += y[e];
        const float m = sum8lanes(s) * (1.0f / 64.0f);
        float s2 = 0.f;
#pragma unroll
        for (int e = 0; e < 8; ++e) { y[e] -= m; s2 += y[e] * y[e]; }
        const float rstd = rsqrtf(sum8lanes(s2) * (1.0f / 64.0f) + GN_EPS);
        unpack8(waf, x0); unpack8(wab, x1); unpack8(wg, x2);
        float bs = 0.f;
#pragma unroll
        for (int e = 0; e < 8; ++e) bs += r[e] * k[e] * (2.0f + (x0[e] + x1[e] - 2.0f) * ka[e]) * rk[e];
        const float bon = sum8lanes(bs);
        float o[8];
#pragma unroll
        for (int e = 0; e < 8; ++e) o[e] = (y[e] * rstd * lg[e] + lb[e] + bon * v[e]) * x2[e];
        u32x4 w; w.x = cvt_pk_bf16(o[0], o[1]); w.y = cvt_pk_bf16(o[2], o[3]); w.z = cvt_pk_bf16(o[4], o[5]); w.w = cvt_pk_bf16(o[6], o[7]);
        *(u32x4*)(amix + (size_t)tok * DM + 512 + cb) = w;
    }
}

__device__ __forceinline__ void ln_phase(const Ctx& c, float* Z, bf16_t* ZB, const float* g, const float* bta, float* O) {
    for (int row0 = c.gw; row0 < NTOK; row0 += 2 * c.NGW) {
        f32x4 v[2][8]; float s[2] = {0.f, 0.f};
#pragma unroll
        for (int u = 0; u < 2; ++u) { const f32x4* zr = (const f32x4*)(Z + (size_t)(row0 + u * c.NGW) * DM) + c.lane;
#pragma unroll
            for (int j = 0; j < 8; ++j) v[u][j] = zr[64 * j]; }
#pragma unroll
        for (int u = 0; u < 2; ++u)
#pragma unroll
            for (int j = 0; j < 8; ++j) s[u] += (v[u][j][0] + v[u][j][1]) + (v[u][j][2] + v[u][j][3]);
        float mean[2], s2[2] = {0.f, 0.f}, rstd[2];
#pragma unroll
        for (int u = 0; u < 2; ++u) mean[u] = wave_sum(s[u]) * (1.0f / DM);
#pragma unroll
        for (int u = 0; u < 2; ++u)
#pragma unroll
            for (int j = 0; j < 8; ++j) { v[u][j] = v[u][j] - mean[u]; s2[u] += (v[u][j][0] * v[u][j][0] + v[u][j][1] * v[u][j][1]) + (v[u][j][2] * v[u][j][2] + v[u][j][3] * v[u][j][3]); }
#pragma unroll
        for (int u = 0; u < 2; ++u) rstd[u] = rsqrtf(wave_sum(s2[u]) * (1.0f / DM) + LN_EPS);
#pragma unroll
        for (int j = 0; j < 8; ++j) { const f32x4 gg = ((const f32x4*)g)[c.lane + 64 * j], bb = ((const f32x4*)bta)[c.lane + 64 * j];
#pragma unroll
            for (int u = 0; u < 2; ++u) { const size_t row = (size_t)(row0 + u * c.NGW);
                const f32x4 o = v[u][j] * rstd[u] * gg + bb;
                if (O) ((f32x4*)(O + row * DM))[c.lane + 64 * j] = o;
                if (ZB) { u32x2 w; w.x = cvt_pk_bf16(o[0], o[1]); w.y = cvt_pk_bf16(o[2], o[3]); ((u32x2*)(ZB + row * DM))[c.lane + 64 * j] = w; } } }
    }
}


#define XB_TMO      128
#define XB_XCNT(j)  (256  + 64 * (j))
#define XB_XSUB(j)  (1280 + 64 * (j))
#define XB_XGEN(j)  (2304 + 64 * (j))
#define XB_TOP      3328
#define XB_TOPGEN   3392
#define XCD_BAR_WORDS 3456
#define XB_SPIN_CAP (1u << 18)
__device__ __forceinline__ unsigned xb_ld(unsigned* p)              { return __hip_atomic_load(p, __ATOMIC_RELAXED, __HIP_MEMORY_SCOPE_AGENT); }
__device__ __forceinline__ unsigned xb_add(unsigned* p, unsigned v) { return __hip_atomic_fetch_add(p, v, __ATOMIC_RELAXED, __HIP_MEMORY_SCOPE_AGENT); }
__device__ __forceinline__ unsigned xb_xcc_id() { return (unsigned)__builtin_amdgcn_s_getreg((3 << 11) | 20) & 0xFu; }
#define XB_SPIN(cond, bar) do { unsigned _sp = 0; while (cond) { __builtin_amdgcn_s_sleep(1); \
    if ((++_sp & 255u) == 0u) { if (xb_ld(&(bar)[XB_TMO])) break; if (_sp > XB_SPIN_CAP) { atomicAdd(&(bar)[XB_TMO], 1u); break; } } } } while (0)
struct XcdBarrier { unsigned* bar; unsigned x; volatile LAS unsigned* st; };
__device__ __forceinline__ XcdBarrier xcd_barrier_post(unsigned* bar, volatile LAS unsigned* st) {
    XcdBarrier b; b.bar = bar; b.x = xb_xcc_id(); b.st = st;
    if (threadIdx.x == 0) (void)xb_add(&bar[XB_XCNT(b.x)], 1u);
    return b;
}
__device__ __forceinline__ void xcd_barrier_complete(unsigned* bar, unsigned x, unsigned& nloc, unsigned& nx) {
    const unsigned G = gridDim.x * gridDim.y * gridDim.z;
    unsigned sum, cnt, mine, sp = 0u;
    for (;;) {
        sum = 0u; cnt = 0u; mine = 0u;
#pragma unroll
        for (unsigned j = 0; j < 16; ++j) { const unsigned c = xb_ld(&bar[XB_XCNT(j)]); sum += c; cnt += (c > 0u) ? 1u : 0u; mine = (j == x) ? c : mine; }
        if (sum == G) break;
        __builtin_amdgcn_s_sleep(1);
        if ((++sp & 255u) == 0u) { if (xb_ld(&bar[XB_TMO])) break; if (sp > XB_SPIN_CAP) { atomicAdd(&bar[XB_TMO], 1u); break; } }
    }
    nloc = mine > 0u ? mine : 1u; nx = cnt > 0u ? cnt : 1u;
}
__device__ __forceinline__ void xcd_barrier(const XcdBarrier& b) {
    asm volatile("s_waitcnt vmcnt(0)" ::: "memory");
    __syncthreads();
    if (threadIdx.x == 0) {
        unsigned* bar = b.bar;
        __builtin_amdgcn_s_waitcnt(0);
        unsigned nloc = b.st[0], nx = b.st[1];
        if (nloc == 0u) { xcd_barrier_complete(bar, b.x, nloc, nx); b.st[0] = nloc; b.st[1] = nx; }
        const unsigned old = xb_add(&bar[XB_XSUB(b.x)], 1u);
        const unsigned gen = old / nloc;
        if (old + 1u == (gen + 1u) * nloc) {
            __builtin_amdgcn_fence(__ATOMIC_RELEASE, "agent");
            asm volatile("s_waitcnt vmcnt(0)" ::: "memory");
            const unsigned og = xb_add(&bar[XB_TOP], 1u);
            const unsigned tg = og / nx;
            if (og + 1u == (tg + 1u) * nx) xb_add(&bar[XB_TOPGEN], 1u);
            else XB_SPIN(xb_ld(&bar[XB_TOPGEN]) == tg, bar);
            __builtin_amdgcn_fence(__ATOMIC_ACQUIRE, "agent");
            xb_add(&bar[XB_XGEN(b.x)], 1u);
            asm volatile("s_waitcnt vmcnt(0)" ::: "memory");
        } else {
            XB_SPIN(xb_ld(&bar[XB_XGEN(b.x)]) == gen, bar);
            __builtin_amdgcn_fence(__ATOMIC_ACQUIRE, "agent");
            asm volatile("s_waitcnt vmcnt(0)" ::: "memory");
        }
    }
    __syncthreads();
}

template <bool OUT_F32> __device__ __forceinline__ void ln_bf16_phase(const Ctx& c, const bf16_t* Z, void* Ov, const float* g, const float* bta) {
    for (int row0 = c.gw; row0 < NTOK; row0 += 2 * c.NGW) {
        float v[2][32]; float s[2] = {0.f, 0.f};
#pragma unroll
        for (int u = 0; u < 2; ++u) { const u32x4* zr = (const u32x4*)(Z + (size_t)(row0 + u * c.NGW) * DM) + c.lane;
#pragma unroll
            for (int j = 0; j < 4; ++j) { const u32x4 w = __builtin_nontemporal_load(zr + 64 * j);
#pragma unroll
                for (int e = 0; e < 4; ++e) { v[u][8 * j + 2 * e] = __uint_as_float(w[e] << 16); v[u][8 * j + 2 * e + 1] = __uint_as_float(w[e] & 0xffff0000u); } } }
#pragma unroll
        for (int u = 0; u < 2; ++u)
#pragma unroll
            for (int e = 0; e < 32; ++e) s[u] += v[u][e];
        float mean[2], s2[2] = {0.f, 0.f}, rstd[2];
#pragma unroll
        for (int u = 0; u < 2; ++u) mean[u] = wave_sum_dpp(s[u]) * (1.0f / DM);
#pragma unroll
        for (int u = 0; u < 2; ++u)
#pragma unroll
            for (int e = 0; e < 32; ++e) { v[u][e] -= mean[u]; s2[u] += v[u][e] * v[u][e]; }
#pragma unroll
        for (int u = 0; u < 2; ++u) rstd[u] = rsqrtf(wave_sum_dpp(s2[u]) * (1.0f / DM) + LN_EPS);
#pragma unroll
        for (int j = 0; j < 4; ++j) { const f32x4 g0 = ((const f32x4*)g)[2 * (c.lane + 64 * j)], g1 = ((const f32x4*)g)[2 * (c.lane + 64 * j) + 1];
            const f32x4 b0 = ((const f32x4*)bta)[2 * (c.lane + 64 * j)], b1 = ((const f32x4*)bta)[2 * (c.lane + 64 * j) + 1];
#pragma unroll
            for (int u = 0; u < 2; ++u) { float o[8];
#pragma unroll
                for (int e = 0; e < 4; ++e) { o[e] = v[u][8 * j + e] * rstd[u] * g0[e] + b0[e]; o[4 + e] = v[u][8 * j + 4 + e] * rstd[u] * g1[e] + b1[e]; }
                if (OUT_F32) { f32x4* op = (f32x4*)((float*)Ov + (size_t)(row0 + u * c.NGW) * DM) + 2 * (c.lane + 64 * j);
                    op[0] = (f32x4){o[0], o[1], o[2], o[3]}; op[1] = (f32x4){o[4], o[5], o[6], o[7]}; }
                else { u32x4 w; w.x = cvt_pk_bf16(o[0], o[1]); w.y = cvt_pk_bf16(o[2], o[3]); w.z = cvt_pk_bf16(o[4], o[5]); w.w = cvt_pk_bf16(o[6], o[7]);
                    ((u32x4*)((bf16_t*)Ov + (size_t)(row0 + u * c.NGW) * DM))[c.lane + 64 * j] = w; } } }
    }
}

constexpr int N_PHASES = 11;
constexpr int LDS_BYTES = 8 * SLOT + 2 * YBUF;

#ifndef PROBE_REP_PHASE
#define PROBE_REP_PHASE -1
#endif
#define PHASE(n) if (a.ph_lo <= (n) && (n) < a.ph_hi) for (int rep_ = 0; rep_ < ((n) == PROBE_REP_PHASE ? 2 : 1); ++rep_)
#define SEAM(n) do { if (a.ph_lo < (n) && (n) < a.ph_hi) xcd_barrier(xb); __syncthreads(); } while (0)
__global__ void __launch_bounds__(512, 2) fwd_megakernel(Args a) {
    extern __shared__ __attribute__((aligned(16))) unsigned char smem[];
    LAS unsigned char* lds = (LAS unsigned char*)smem;
    const int G = gridDim.x, bid = blockIdx.x;
    __shared__ uint4 xb_words;
    if (threadIdx.x == 0) xb_words = make_uint4(0u, 0u, 0u, 0u);
    __syncthreads();
    XcdBarrier xb; xb.bar = (unsigned*)(a.ws + WS_BAR); xb.x = 0; xb.st = (volatile LAS unsigned*)&xb_words;
    if (a.ph_hi - a.ph_lo > 1) xb = xcd_barrier_post((unsigned*)(a.ws + WS_BAR), (volatile LAS unsigned*)&xb_words);
    if (a.ph_hi > 1000) cg::this_grid().sync();
    PHASE(0) { Ctx c(a, lds); phase0(c); }
    SEAM(1);
    PHASE(1) {
        pg8::Order<0> S; S.init(NTOK, INP, G, bid, a.ws + WS_XB, DM, a.ws + WS_WINT, DM);
        pg8::EpiBf16 E{(bf16_t*)(a.ws + WS_PROJ), INP};
        pg8::gemm_phase(lds, DM, DM, DM, S, E);
        __syncthreads();
        if (G == 256 && bid >= 128) phase1_fill(a, lds, bid - 128, 128);
        else if (G != 256) phase1_fill(a, lds, bid, G); }
    SEAM(2);
    PHASE(2) { Ctx c(a, lds); phase2(c); }
    SEAM(3);
    PHASE(3) {
        pg8::Order<3> S; S.init(NTOK, 6144, G, bid, (unsigned char*)a.out + DO_ALORA, 512, a.ws + WS_WLT, 128);
        pg8::EpiLora E{(bf16_t*)(a.ws + WS_OUT5), (const float*)(a.ws + WS_BIAS), 0};
        pg8::gemm_phase(lds, 128, 512, 128, S, E); }
    __syncthreads();
    PHASE(3) {
        pg8::Order<0> S; S.init(NTOK, 1536, G, bid, (unsigned char*)a.out + DO_ALORA + 512, 512, a.ws + WS_WLT + 2 * MiB, 256);
        pg8::EpiLora E{(bf16_t*)(a.ws + WS_OUT5), (const float*)(a.ws + WS_BIAS), 4};
        pg8::gemm_phase(lds, 256, 512, 256, S, E); }
    __syncthreads();
    PHASE(3) {
        pg8::Order<0> S; S.init(1024, NTOK, G, bid, a.ws + WS_CDFT, 512, a.ws + WS_PROJ, INP);
        pg8::EpiCdft E{(bf16_t*)((unsigned char*)a.out + DO_FABT)};
        pg8::gemm_phase(lds, 512, 512, INP, S, E); }
    SEAM(4);
    PHASE(4) {
        if (bid >= 192) {
            pg8::Order<2> S; S.init(NTOK, 512, 64, bid - 192, a.ws + WS_DFTM, 4096, (unsigned char*)a.out + DO_FABT, 4096);
            pg8::EpiBf16 E{(bf16_t*)(a.ws + WS_AMIX), DM};
            pg8::gemm_phase(lds, 4096, 4096, 4096, S, E);
            __syncthreads();
            {
                const int lane = threadIdx.x & 63, wave = __builtin_amdgcn_readfirstlane(threadIdx.x >> 6);
                LAS float* scr = (LAS float*)(lds + wave * 16384);
                for (int it = (bid - 192) * 8 + wave; it < 88 * 64; it += 64 * 8) tr_item<0>(a.in[22], DFF, DM, (bf16_t*)((unsigned char*)a.out + DO_WDNT), DFF, scr, it, lane); }
        } else scan2_phase(a, lds); }
    SEAM(5);
    PHASE(5) { Ctx c(a, lds); post_phase(c); }
    SEAM(6);
    PHASE(6) {
        pg8::Order<0> S; S.init(NTOK, DM, G, bid, a.ws + WS_AMIX, DM, a.ws + WS_WOUTT, DM);
        pg8::EpiResToBf16 E{(bf16_t*)(a.ws + WS_H), a.in[0]};
        pg8::gemm_phase(lds, DM, DM, DM, S, E); }
    SEAM(7);
    PHASE(7) {
        Ctx c(a, lds);
        ln_bf16_phase<false>(c, (const bf16_t*)(a.ws + WS_H), a.ws + WS_HB, a.in[18], a.in[19]);
        LAS float* scr = (LAS float*)(lds + c.wave * 16384);
        for (int it = c.gw; it < 32 * 176; it += c.NGW) tr_item<1>(a.in[20], DM, DFF, (bf16_t*)(a.ws + WS_WGUT), DM, scr, it, c.lane);
        for (int it = c.gw; it < 32 * 176; it += c.NGW) tr_item<2>(a.in[21], DM, DFF, (bf16_t*)(a.ws + WS_WGUT), DM, scr, it, c.lane);
    }
    SEAM(8);
    PHASE(8) {
        pg8::Order<0> S; S.init(NTOK, 2 * DFF, G, bid, a.ws + WS_HB, DM, a.ws + WS_WGUT, DM);
        pg8::EpiSwiglu E{(bf16_t*)(a.ws + WS_FFA)};
        pg8::gemm_phase(lds, DM, DM, DM, S, E); }
    SEAM(9);
    PHASE(9) {
        pg8::Order<0> S; S.init(NTOK, DM, G, bid, a.ws + WS_FFA, DFF, (unsigned char*)a.out + DO_WDNT, DFF);
        pg8::EpiResBfToBf E{(bf16_t*)(a.ws + WS_H), (const bf16_t*)(a.ws + WS_HB)};
        pg8::gemm_phase(lds, DFF, DFF, DFF, S, E); }
    SEAM(10);
    PHASE(10) { Ctx c(a, lds); ln_bf16_phase<true>(c, (const bf16_t*)(a.ws + WS_H), a.out, a.in[23], a.in[24]); }
}

extern "C" void kernel_launch(void* const* d_in, const int* in_sizes, int n_in, void* d_out, int out_size, void* d_ws, size_t ws_size, hipStream_t stream) {
    static int grid = 0;
    if (grid == 0) {
        if (n_in != 25 || out_size != NTOK * DM || ws_size < WS_END) { fprintf(stderr, "kernel_launch: unexpected shapes (n_in %d out %d ws %zu need %zu)\n", n_in, out_size, ws_size, (size_t)WS_END); grid = -1; return; }
        int dev = 0, cus = 0, per_cu = 0;
        hipGetDevice(&dev); hipDeviceGetAttribute(&cus, hipDeviceAttributeMultiprocessorCount, dev);
        if (hipFuncSetAttribute((const void*)fwd_megakernel, hipFuncAttributeMaxDynamicSharedMemorySize, LDS_BYTES) != hipSuccess) { fprintf(stderr, "kernel_launch: hipFuncSetAttribute failed\n"); grid = -1; return; }
        hipOccupancyMaxActiveBlocksPerMultiprocessor(&per_cu, (const void*)fwd_megakernel, 512, LDS_BYTES);
        if (per_cu < 1) { fprintf(stderr, "kernel_launch: occupancy query says %d blocks per CU\n", per_cu); (void)hipGetLastError(); per_cu = 1; }
        grid = cus < 256 ? cus : 256;
    }
    if (grid < 0) return;
    Args a{};
    for (int i = 0; i < 25; ++i) a.in[i] = (const float*)d_in[i];
    a.out = (float*)d_out; a.ws = (unsigned char*)d_ws;
#if N_LAUNCH_MODE == 1
    if (hipMemsetAsync((unsigned char*)d_ws + WS_BAR, 0, XCD_BAR_WORDS * 4, stream) != hipSuccess) { fprintf(stderr, "kernel_launch: memset of the barrier words failed\n"); return; }
    a.ph_lo = 0; a.ph_hi = N_PHASES;
    void* args[] = {&a};
    hipError_t e = hipLaunchCooperativeKernel((const void*)fwd_megakernel, dim3(grid), dim3(512), args, LDS_BYTES, stream);
    if (e != hipSuccess) fprintf(stderr, "cooperative launch failed: %s (grid %d)\n", hipGetErrorString(e), grid);
#else
    for (int ph = 0; ph < N_PHASES; ++ph) { a.ph_lo = ph; a.ph_hi = ph + 1;
        hipLaunchKernelGGL(fwd_megakernel, dim3(grid), dim3(512), LDS_BYTES, stream, a); }
#endif
}
```

```cpp
#include <hip/hip_runtime.h>
#include <hip/hip_cooperative_groups.h>
#include <cstdio>
#include <cstdint>
namespace cg = cooperative_groups;

#ifndef N_LAUNCH_MODE
#define N_LAUNCH_MODE 1
#endif

#define LAS __attribute__((address_space(3)))
typedef unsigned short bf16_t;
typedef short bf16x8 __attribute__((ext_vector_type(8)));
typedef float f32x4 __attribute__((ext_vector_type(4)));
typedef float f32x2 __attribute__((ext_vector_type(2)));
typedef unsigned u32x4 __attribute__((ext_vector_type(4)));
typedef unsigned u32x2 __attribute__((ext_vector_type(2)));

constexpr int NTOK = 16384, DM = 2048, SEQ = 2048, NB = 8;
constexpr int INP = 5632;
constexpr int RW = 1536, NH = 24;
constexpr int R_OFF = 512, K_OFF = 2048, V_OFF = 3584, G_OFF = 5120;
constexpr int DFF = 5632;
constexpr float ALPHA = 1.189207115002721f;
constexpr float LN_EPS = 1e-5f, GN_EPS = 64e-5f;

constexpr size_t MiB = 1048576;
constexpr size_t WS_RA    = 0;
constexpr size_t WS_XB    = WS_RA;
constexpr size_t WS_WINT  = 88 * MiB + 176 * MiB;
constexpr size_t WS_AMIX  = WS_RA;
constexpr size_t WS_DFTM  = WS_RA + 64 * MiB;
constexpr size_t WS_WOUTT = WS_RA + 80 * MiB;
constexpr size_t WS_WGUT  = WS_RA;
constexpr size_t WS_PROJ  = 88 * MiB;
constexpr size_t WS_FFA   = WS_PROJ;
constexpr size_t WS_OUT5  = WS_PROJ + 176 * MiB;
constexpr size_t WS_H     = WS_OUT5;
constexpr size_t WS_HB    = WS_OUT5 + 128 * MiB;
constexpr size_t WS_SMALL = WS_OUT5 + 240 * MiB;
constexpr size_t WS_WLT   = WS_SMALL;
constexpr size_t WS_CDFT  = WS_SMALL + 4 * MiB;
constexpr size_t WS_BIAS  = WS_SMALL + 5 * MiB;
constexpr size_t WS_BAR   = WS_BIAS + 65536;
constexpr size_t WS_END   = WS_SMALL + 6 * MiB;
constexpr size_t DO_Y = 0, DO_WDNT = 48 * MiB, DO_FABT = 96 * MiB, DO_ALORA = 0;
constexpr size_t OUT5_STRIDE = (size_t)NTOK * RW;

struct Args {
    const float* in[25];
    float* out;
    unsigned char* ws;
    int ph_lo, ph_hi;
};

typedef __bf16 bf16v2 __attribute__((ext_vector_type(2)));
__device__ __forceinline__ unsigned cvt_pk_bf16(float lo, float hi) { const f32x2 v = {lo, hi}; return __builtin_bit_cast(unsigned, __builtin_convertvector(v, bf16v2)); }
__device__ __forceinline__ float bf2f(bf16_t h) { return __uint_as_float(((unsigned)h) << 16); }
__device__ __forceinline__ bf16_t f2bf(float f) { return (bf16_t)(cvt_pk_bf16(f, 0.f) & 0xffffu); }
__device__ __forceinline__ float wave_sum(float v) {
#pragma unroll
    for (int o = 1; o < 64; o <<= 1) v += __shfl_xor(v, o);
    return v;
}
__device__ __forceinline__ float wave_sum_dpp(float v) {
    v += __builtin_bit_cast(float, __builtin_amdgcn_update_dpp(0, __builtin_bit_cast(int, v), 0xB1, 0xf, 0xf, true));
    v += __builtin_bit_cast(float, __builtin_amdgcn_update_dpp(0, __builtin_bit_cast(int, v), 0x4E, 0xf, 0xf, true));
    v += __builtin_bit_cast(float, __builtin_amdgcn_update_dpp(0, __builtin_bit_cast(int, v), 0x141, 0xf, 0xf, true));
    v += __builtin_bit_cast(float, __builtin_amdgcn_update_dpp(0, __builtin_bit_cast(int, v), 0x140, 0xf, 0xf, true));
    v += __builtin_bit_cast(float, __builtin_amdgcn_update_dpp(0, __builtin_bit_cast(int, v), 0x142, 0xa, 0xf, false));
    v += __builtin_bit_cast(float, __builtin_amdgcn_update_dpp(0, __builtin_bit_cast(int, v), 0x143, 0xc, 0xf, false));
    return __builtin_bit_cast(float, __builtin_amdgcn_readlane(__builtin_bit_cast(int, v), 63));
}
__device__ __forceinline__ float sigmoidf_(float z) { return __builtin_amdgcn_rcpf(1.0f + __expf(-z)); }
#define LDS_WAIT() asm volatile("s_waitcnt lgkmcnt(0)" ::: "memory")
#define RAW_BARRIER() do { asm volatile("s_waitcnt lgkmcnt(0)" ::: "memory"); __builtin_amdgcn_s_barrier(); asm volatile("" ::: "memory"); } while (0)
constexpr int INP_ = 5632, SEQ_ = 2048;
__device__ __forceinline__ float shifted(const bf16_t* p, int t, float mu) {
    const float fp = t > 0 ? 1.0f : 0.0f, fn = t < SEQ_ - 1 ? 1.0f : 0.0f;
    const bf16_t* q0 = t > 0 ? p - INP_ : p; const bf16_t* q1 = t < SEQ_ - 1 ? p + INP_ : p;
    const float p0 = bf2f(p[0]), pp = bf2f(q0[0]) * fp, pn = bf2f(q1[0]) * fn;
    return p0 + (0.5f * (pp + pn) - p0) * mu;
}


namespace pg8 {
constexpr int BM = 256, BK = 64, HALF = 128, HTB = HALF * BK * 2, STAGE_BYTES = 8 * HTB, NXCD = 8, WGM = 8;
__host__ __device__ __forceinline__ int lds_byte(int r, int c) { const int st = (r >> 4) * 2 + (c >> 5), rr = r & 15, cc = c & 31, ob = rr * 64 + cc * 2; return st * 1024 + (ob ^ (((ob >> 9) & 1) << 5)); }
__host__ __device__ __forceinline__ void stage_rc(int b, int& R, int& C) { const int st = b / 1024, sb = b % 1024, swz = sb ^ (((sb >> 9) & 1) << 5); R = (st >> 1) * 16 + swz / 64; C = (st & 1) * 32 + (swz % 64) / 2; }
__host__ __device__ __forceinline__ int perm32(int rho) { const int n = rho >> 4, i = rho & 15; return 8 * (i >> 2) + 4 * n + (i & 3); }
struct Unit { int pm, pn; };

template <int MODE> struct Order {
    int nM, nN, nwg, G, c;
    const char* A; const char* B; size_t tA, tB;
    __device__ void init(int M, int N, int G_, int c_, const void* A_, int lda, const void* B_, int ldb) {
        nM = M / BM; nN = N / BM; nwg = nM * nN; G = G_; c = c_; A = (const char*)A_; B = (const char*)B_; tA = (size_t)BM * lda * 2; tB = (size_t)BM * ldb * 2; }
    __device__ bool next(int i, Unit& u) const {
        const long L = (long)i * G + c; if (L >= nwg) return false;
        int wgid = (int)L; { const int q = nwg / NXCD, r = nwg % NXCD, xcd = wgid % NXCD, off = wgid / NXCD; wgid = (xcd < r ? xcd * (q + 1) : r * (q + 1) + (xcd - r) * q) + off; }
        const int nig = WGM * nN, gid = wgid / nig, fm = gid * WGM, gsz = (nM - fm) < WGM ? (nM - fm) : WGM;
        u.pm = fm + ((wgid % nig) % gsz); u.pn = (wgid % nig) / gsz; return true;
    }
    __device__ __forceinline__ const char* pa(const Unit& u) const {
        if (MODE == 1) return A + (size_t)u.pm * tA + (u.pn >= 24 ? 512 : 0);
        if (MODE == 3) return A + (size_t)u.pm * tA + (u.pn >= 12 ? 256 : 0);
        if (MODE == 2) return A + (size_t)(u.pm & 7) * tA;
        return A + (size_t)u.pm * tA; }
    __device__ __forceinline__ const char* pb(const Unit& u) const {
        if (MODE == 2) return B + (size_t)(u.pm >> 3) * ((size_t)512 * 4096 * 2) + (size_t)u.pn * tB;
        return B + (size_t)u.pn * tB; }
};

struct EpiBf16 {
    static constexpr bool PERM = true;
    bf16_t* O; int ldc;
    __device__ __forceinline__ void operator()(const f32x4 (&acc)[2][2][4][2], const Unit& u, int wr, int wc, int fr, int fq) const {
        const int row0 = u.pm * BM + wr * 64 + fr, col0 = u.pn * BM + wc * 32 + 8 * fq;
#pragma unroll
        for (int ai = 0; ai < 2; ++ai)
#pragma unroll
            for (int m = 0; m < 4; ++m) { bf16_t* rowp = O + (size_t)(row0 + ai * HALF + m * 16) * ldc + col0;
#pragma unroll
                for (int bj = 0; bj < 2; ++bj) { const f32x4 v0 = acc[ai][bj][m][0], v1 = acc[ai][bj][m][1];
                    u32x4 w; w.x = cvt_pk_bf16(v0[0], v0[1]); w.y = cvt_pk_bf16(v0[2], v0[3]); w.z = cvt_pk_bf16(v1[0], v1[1]); w.w = cvt_pk_bf16(v1[2], v1[3]);
                    *(u32x4*)(rowp + bj * HALF) = w; } }
    }
};
struct EpiLora {
    static constexpr bool PERM = true;
    bf16_t* O; const float* bias; int qoff;
    __device__ __forceinline__ void operator()(const f32x4 (&acc)[2][2][4][2], const Unit& u, int wr, int wc, int fr, int fq) const {
        const int q = u.pn / 6 + qoff, cb = (u.pn % 6) * BM + wc * 32 + 8 * fq;
        const int row0 = u.pm * BM + wr * 64 + fr;
        bf16_t* base = O + (size_t)q * OUT5_STRIDE + cb;
        const float* bp = bias + (q & 3) * RW + cb;
        const float sc = (q < 2) ? -0.6065306597126334f : 1.0f;
#pragma unroll
        for (int ai = 0; ai < 2; ++ai)
#pragma unroll
            for (int m = 0; m < 4; ++m) { bf16_t* rowp = base + (size_t)(row0 + ai * HALF + m * 16) * RW;
#pragma unroll
                for (int bj = 0; bj < 2; ++bj) { f32x4 v0 = acc[ai][bj][m][0], v1 = acc[ai][bj][m][1];
                    if (q < 4) { const f32x4 c0 = *(const f32x4*)(bp + bj * HALF), c1 = *(const f32x4*)(bp + bj * HALF + 4);
#pragma unroll
                        for (int j = 0; j < 4; ++j) { v0[j] = sc * sigmoidf_(v0[j] + c0[j]); v1[j] = sc * sigmoidf_(v1[j] + c1[j]); } }
                    u32x4 w; w.x = cvt_pk_bf16(v0[0], v0[1]); w.y = cvt_pk_bf16(v0[2], v0[3]); w.z = cvt_pk_bf16(v1[0], v1[1]); w.w = cvt_pk_bf16(v1[2], v1[3]);
                    *(u32x4*)(rowp + bj * HALF) = w; }
                asm volatile("" ::: "memory"); }
    }
};
struct EpiCdft {
    static constexpr bool PERM = true;
    bf16_t* O;
    __device__ __forceinline__ void operator()(const f32x4 (&acc)[2][2][4][2], const Unit& u, int wr, int wc, int fr, int fq) const {
        const int row0 = u.pm * BM + wr * 64 + fr, tok0 = u.pn * BM + wc * 32 + 8 * fq;
        const int b = tok0 >> 11, pos0 = tok0 & 2047;
#pragma unroll
        for (int ai = 0; ai < 2; ++ai)
#pragma unroll
            for (int m = 0; m < 4; ++m) { const int mm = row0 + ai * HALF + m * 16, part = mm >> 9, np = mm & 511;
                bf16_t* rowp = O + ((size_t)(b * 512 + np) * 4096 + part * 2048 + pos0);
#pragma unroll
                for (int bj = 0; bj < 2; ++bj) { const f32x4 v0 = acc[ai][bj][m][0], v1 = acc[ai][bj][m][1];
                    u32x4 w; w.x = cvt_pk_bf16(v0[0], v0[1]); w.y = cvt_pk_bf16(v0[2], v0[3]); w.z = cvt_pk_bf16(v1[0], v1[1]); w.w = cvt_pk_bf16(v1[2], v1[3]);
                    *(u32x4*)(rowp + bj * HALF) = w; } }
    }
};
struct EpiResF32 {
    static constexpr bool PERM = false;
    float* C; const float* res;
    __device__ __forceinline__ void operator()(const f32x4 (&acc)[2][2][4][2], const Unit& u, int wr, int wc, int fr, int fq) const {
        const int row0 = u.pm * BM + wr * 64 + fr, col0 = u.pn * BM + wc * 32 + 4 * fq;
#pragma unroll
        for (int ai = 0; ai < 2; ++ai)
#pragma unroll
            for (int m = 0; m < 4; ++m) { const size_t off = (size_t)(row0 + ai * HALF + m * 16) * DM + col0;
#pragma unroll
                for (int bj = 0; bj < 2; ++bj)
#pragma unroll
                    for (int n = 0; n < 2; ++n) { const f32x4 rs = *(const f32x4*)(res + off + bj * HALF + n * 16); *(f32x4*)(C + off + bj * HALF + n * 16) = acc[ai][bj][m][n] + ALPHA * rs; }
                asm volatile("" ::: "memory"); }
    }
};
struct EpiResToBf16 {
    static constexpr bool PERM = true;
    bf16_t* O; const float* res;
    __device__ __forceinline__ void operator()(const f32x4 (&acc)[2][2][4][2], const Unit& u, int wr, int wc, int fr, int fq) const {
        const int row0 = u.pm * BM + wr * 64 + fr, col0 = u.pn * BM + wc * 32 + 8 * fq;
#pragma unroll
        for (int ai = 0; ai < 2; ++ai)
#pragma unroll
            for (int m = 0; m < 4; ++m) { const size_t off = (size_t)(row0 + ai * HALF + m * 16) * DM + col0;
#pragma unroll
                for (int bj = 0; bj < 2; ++bj) { const f32x4 r0 = __builtin_nontemporal_load((const f32x4*)(res + off + bj * HALF)), r1 = __builtin_nontemporal_load((const f32x4*)(res + off + bj * HALF + 4));
                    const f32x4 v0 = acc[ai][bj][m][0] + ALPHA * r0, v1 = acc[ai][bj][m][1] + ALPHA * r1;
                    u32x4 w; w.x = cvt_pk_bf16(v0[0], v0[1]); w.y = cvt_pk_bf16(v0[2], v0[3]); w.z = cvt_pk_bf16(v1[0], v1[1]); w.w = cvt_pk_bf16(v1[2], v1[3]);
                    *(u32x4*)(O + off + bj * HALF) = w; }
                asm volatile("" ::: "memory"); }
    }
};
struct EpiResBfToBf {
    static constexpr bool PERM = true;
    bf16_t* O; const bf16_t* res;
    __device__ __forceinline__ void operator()(const f32x4 (&acc)[2][2][4][2], const Unit& u, int wr, int wc, int fr, int fq) const {
        const int row0 = u.pm * BM + wr * 64 + fr, col0 = u.pn * BM + wc * 32 + 8 * fq;
#pragma unroll
        for (int ai = 0; ai < 2; ++ai)
#pragma unroll
            for (int m = 0; m < 4; ++m) { const size_t off = (size_t)(row0 + ai * HALF + m * 16) * DM + col0;
#pragma unroll
                for (int bj = 0; bj < 2; ++bj) { const u32x4 rb = __builtin_nontemporal_load((const u32x4*)(res + off + bj * HALF));
                    const f32x4 r0 = {__uint_as_float(rb.x << 16), __uint_as_float(rb.x & 0xffff0000u), __uint_as_float(rb.y << 16), __uint_as_float(rb.y & 0xffff0000u)};
                    const f32x4 r1 = {__uint_as_float(rb.z << 16), __uint_as_float(rb.z & 0xffff0000u), __uint_as_float(rb.w << 16), __uint_as_float(rb.w & 0xffff0000u)};
                    const f32x4 v0 = acc[ai][bj][m][0] + ALPHA * r0, v1 = acc[ai][bj][m][1] + ALPHA * r1;
                    u32x4 w; w.x = cvt_pk_bf16(v0[0], v0[1]); w.y = cvt_pk_bf16(v0[2], v0[3]); w.z = cvt_pk_bf16(v1[0], v1[1]); w.w = cvt_pk_bf16(v1[2], v1[3]);
                    *(u32x4*)(O + off + bj * HALF) = w; }
                asm volatile("" ::: "memory"); }
    }
};
struct EpiResBf16 {
    static constexpr bool PERM = false;
    float* C; const bf16_t* res;
    __device__ __forceinline__ void operator()(const f32x4 (&acc)[2][2][4][2], const Unit& u, int wr, int wc, int fr, int fq) const {
        const int row0 = u.pm * BM + wr * 64 + fr, col0 = u.pn * BM + wc * 32 + 4 * fq;
#pragma unroll
        for (int ai = 0; ai < 2; ++ai)
#pragma unroll
            for (int m = 0; m < 4; ++m) { const size_t off = (size_t)(row0 + ai * HALF + m * 16) * DM + col0;
#pragma unroll
                for (int bj = 0; bj < 2; ++bj)
#pragma unroll
                    for (int n = 0; n < 2; ++n) { const u32x2 rb = *(const u32x2*)(res + off + bj * HALF + n * 16);
                        const f32x4 rs = {__uint_as_float(rb.x << 16), __uint_as_float(rb.x & 0xffff0000u), __uint_as_float(rb.y << 16), __uint_as_float(rb.y & 0xffff0000u)};
                        *(f32x4*)(C + off + bj * HALF + n * 16) = acc[ai][bj][m][n] + ALPHA * rs; }
                asm volatile("" ::: "memory"); }
    }
};
struct EpiSwiglu {
    static constexpr bool PERM = true;
    bf16_t* O;
    __device__ __forceinline__ void operator()(const f32x4 (&acc)[2][2][4][2], const Unit& u, int wr, int wc, int fr, int fq) const {
        const int row0 = u.pm * BM + wr * 64 + fr, col0 = u.pn * HALF + wc * 32 + 8 * fq;
#pragma unroll
        for (int ai = 0; ai < 2; ++ai)
#pragma unroll
            for (int m = 0; m < 4; ++m) { bf16_t* rowp = O + (size_t)(row0 + ai * HALF + m * 16) * DFF + col0;
                f32x4 o0, o1;
#pragma unroll
                for (int j = 0; j < 4; ++j) { const float g0 = acc[ai][0][m][0][j], g1 = acc[ai][0][m][1][j];
                    o0[j] = g0 * sigmoidf_(g0) * acc[ai][1][m][0][j]; o1[j] = g1 * sigmoidf_(g1) * acc[ai][1][m][1][j]; }
                u32x4 w; w.x = cvt_pk_bf16(o0[0], o0[1]); w.y = cvt_pk_bf16(o0[2], o0[3]); w.z = cvt_pk_bf16(o1[0], o1[1]); w.w = cvt_pk_bf16(o1[2], o1[3]);
                *(u32x4*)rowp = w; }
    }
};

template <class Epi, class Sched>
__device__ __forceinline__ void gemm_phase(LAS unsigned char* lds, const int K, const int lda, const int ldb, const Sched& S, const Epi& E) {
    const int tid = threadIdx.x, wid = __builtin_amdgcn_readfirstlane(tid >> 6), lane = tid & 63, wr = wid >> 2, wc = wid & 3, fr = lane & 15, fq = lane >> 4;
    const int nt = K / BK;
    unsigned voffA[2], voffB[2];
#pragma unroll
    for (int i = 0; i < 2; ++i) { int R, C; stage_rc(tid * 16 + i * 8192, R, C); const int Rb = Epi::PERM ? ((R & ~31) + perm32(R & 31)) : R;
        voffA[i] = (unsigned)(R * lda + C) * 2u; voffB[i] = (unsigned)(Rb * ldb + C) * 2u; }
    const size_t kstep = (size_t)(BK * 2);
    const size_t hstepA = (size_t)HALF * lda * 2, hstepB = (size_t)HALF * ldb * 2;
    const unsigned ldsw = (unsigned)wid * 1024u;
    const int aoff = lds_byte(wr * 64 + fr, fq * 8), boff = lds_byte(wc * 32 + fr, fq * 8);
#define PG8_SA(b, h) (((b) * 2 + (h)) * HTB)
#define PG8_SB(b, h) ((4 + (b) * 2 + (h)) * HTB)
#define PG8_STAGE(bufoff, gbase, voff) do { _Pragma("unroll") for (int _i = 0; _i < 2; ++_i) \
        __builtin_amdgcn_global_load_lds((const unsigned*)((const char*)(gbase) + (voff)[_i]), (LAS unsigned*)(lds + (bufoff) + ldsw + _i * 8192), 16, 0, 0); } while (0)
#define PG8_LDA(dst, b, h) do { _Pragma("unroll") for (int m = 0; m < 4; ++m) _Pragma("unroll") for (int k = 0; k < 2; ++k) dst[m][k] = *(const LAS bf16x8*)(lds + PG8_SA(b, h) + aoff + m * 2048 + k * 1024); } while (0)
#define PG8_LDB(dst, b, h) do { _Pragma("unroll") for (int n = 0; n < 2; ++n) _Pragma("unroll") for (int k = 0; k < 2; ++k) dst[n][k] = *(const LAS bf16x8*)(lds + PG8_SB(b, h) + boff + n * 2048 + k * 1024); } while (0)
#define PG8_MMA(ai, bj, At, Bt) do { __builtin_amdgcn_s_setprio(1); _Pragma("unroll") for (int m = 0; m < 4; ++m) _Pragma("unroll") for (int n = 0; n < 2; ++n) _Pragma("unroll") for (int k = 0; k < 2; ++k) \
        acc[ai][bj][m][n] = __builtin_amdgcn_mfma_f32_16x16x32_bf16(Bt[n][k], At[m][k], acc[ai][bj][m][n], 0, 0, 0); __builtin_amdgcn_s_setprio(0); } while (0)
#define PG8_WAIT_V(n) asm volatile("s_waitcnt vmcnt(" #n ")" ::: "memory")
#define PG8_WAIT_L(n) asm volatile("s_waitcnt lgkmcnt(" #n ")" ::: "memory")
#define PG8_BAR __builtin_amdgcn_s_barrier()
#define PG8_SCHED __builtin_amdgcn_sched_barrier(0)
    Unit cur, nxt; int ui = 0;
    if (!S.next(0, cur)) return;
    f32x4 acc[2][2][4][2];
#pragma unroll
    for (int a = 0; a < 2; ++a)
#pragma unroll
        for (int b = 0; b < 2; ++b)
#pragma unroll
            for (int m = 0; m < 4; ++m)
#pragma unroll
                for (int n = 0; n < 2; ++n) acc[a][b][m][n] = (f32x4){0.f, 0.f, 0.f, 0.f};
    bf16x8 At[4][2], B0[2][2], B1[2][2];
    const char* cA = S.pa(cur); const char* cB = S.pb(cur);
    PG8_STAGE(PG8_SB(0, 0), cB, voffB); PG8_STAGE(PG8_SB(0, 1), cB + hstepB, voffB); PG8_STAGE(PG8_SA(0, 0), cA, voffA); PG8_STAGE(PG8_SA(0, 1), cA + hstepA, voffA);
    if (wr == 1) PG8_BAR;
    PG8_WAIT_V(2); PG8_BAR;
    PG8_STAGE(PG8_SB(1, 0), cB + kstep, voffB); PG8_STAGE(PG8_SA(1, 0), cA + kstep, voffA); PG8_STAGE(PG8_SB(1, 1), cB + hstepB + kstep, voffB);
    PG8_WAIT_V(6); PG8_BAR;
    for (;;) {
        const bool has_next = S.next(ui + 1, nxt);
        const char* nA = has_next ? S.pa(nxt) : cA; const char* nB = has_next ? S.pb(nxt) : cB;
        for (int t = 0; t < nt; t += 2) {
            const bool last = (t == nt - 2);
            const char* a1 = cA + (size_t)(t + 1) * kstep;
            const char* a2 = last ? nA : cA + (size_t)(t + 2) * kstep; const char* b2 = last ? nB : cB + (size_t)(t + 2) * kstep;
            const char* a3 = a2 + kstep; const char* b3 = b2 + kstep;
            PG8_LDB(B0, 0, 0); PG8_LDB(B1, 0, 1); PG8_SCHED; PG8_LDA(At, 0, 0); PG8_STAGE(PG8_SA(1, 1), a1 + hstepA, voffA);
            PG8_WAIT_V(8); PG8_WAIT_L(0); PG8_BAR; PG8_MMA(0, 0, At, B0); PG8_MMA(0, 1, At, B1); PG8_BAR; PG8_SCHED;
            PG8_LDA(At, 0, 1); PG8_STAGE(PG8_SB(0, 0), b2, voffB); PG8_STAGE(PG8_SB(0, 1), b2 + hstepB, voffB); PG8_STAGE(PG8_SA(0, 0), a2, voffA);
            PG8_WAIT_V(8); PG8_WAIT_L(0); PG8_BAR; PG8_MMA(1, 0, At, B0); PG8_MMA(1, 1, At, B1); PG8_BAR; PG8_SCHED;
            PG8_LDB(B0, 1, 0); PG8_LDB(B1, 1, 1); PG8_SCHED; PG8_LDA(At, 1, 0); PG8_STAGE(PG8_SA(0, 1), a2 + hstepA, voffA);
            PG8_WAIT_V(8); PG8_WAIT_L(0); PG8_BAR; PG8_MMA(0, 0, At, B0); PG8_MMA(0, 1, At, B1); PG8_BAR; PG8_SCHED;
            PG8_LDA(At, 1, 1); PG8_STAGE(PG8_SB(1, 0), b3, voffB); PG8_STAGE(PG8_SB(1, 1), b3 + hstepB, voffB); PG8_STAGE(PG8_SA(1, 0), a3, voffA);
            PG8_WAIT_V(8); PG8_WAIT_L(0); PG8_BAR; PG8_MMA(1, 0, At, B0); PG8_MMA(1, 1, At, B1); PG8_BAR; PG8_SCHED;
        }
        if (wr == 0) PG8_BAR;
        E(acc, cur, wr, wc, fr, fq);
        if (!has_next) break;
#pragma unroll
        for (int a = 0; a < 2; ++a)
#pragma unroll
            for (int b = 0; b < 2; ++b)
#pragma unroll
                for (int m = 0; m < 4; ++m)
#pragma unroll
                    for (int n = 0; n < 2; ++n) acc[a][b][m][n] = (f32x4){0.f, 0.f, 0.f, 0.f};
        cur = nxt; cA = nA; cB = nB; ++ui;
        if (wr == 1) PG8_BAR;
    }
    PG8_WAIT_V(0);
    PG8_BAR;
#undef PG8_SA
#undef PG8_SB
#undef PG8_STAGE
#undef PG8_LDA
#undef PG8_LDB
#undef PG8_MMA
#undef PG8_WAIT_V
#undef PG8_WAIT_L
#undef PG8_BAR
#undef PG8_SCHED
}
}

template <int MODE> __device__ __forceinline__ void tr_item(const float* W, int K, int N, bf16_t* WT, int ldd, LAS float* scr, int item, int lane) {
    const int nblk = N / 32, kb = item / nblk, nb = item % nblk, k0 = 64 * kb, n0 = 32 * nb;
    float tv[32];
#pragma unroll
    for (int i = 0; i < 32; ++i) tv[i] = __builtin_nontemporal_load(W + (size_t)(k0 + 2 * i + (lane >> 5)) * N + n0 + (lane & 31));
#pragma unroll
    for (int i = 0; i < 32; ++i) scr[(2 * i + (lane >> 5)) * 33 + (lane & 31)] = tv[i];
    LDS_WAIT();
    const int c = lane & 7;
#pragma unroll
    for (int j = 0; j < 4; ++j) { const int n = n0 + (lane >> 3) + 8 * j; const LAS float* s = scr + (8 * c) * 33 + (n - n0);
        u32x4 o; o.x = cvt_pk_bf16(s[0 * 33], s[1 * 33]); o.y = cvt_pk_bf16(s[2 * 33], s[3 * 33]); o.z = cvt_pk_bf16(s[4 * 33], s[5 * 33]); o.w = cvt_pk_bf16(s[6 * 33], s[7 * 33]);
        const int dr = (MODE == 0) ? n : (256 * (n >> 7) + (MODE == 2 ? 128 : 0) + (n & 127));
        *(u32x4*)(WT + (size_t)dr * ldd + k0 + 8 * c) = o; }
    LDS_WAIT();
}

struct Ctx {
    const Args& a; LAS unsigned char* lds; int lane, wave, bid, G, gw, NGW, gtid, GT;
    __device__ __forceinline__ Ctx(const Args& a_, LAS unsigned char* l) : a(a_), lds(l), lane(threadIdx.x & 63), wave(__builtin_amdgcn_readfirstlane(threadIdx.x >> 6)), bid(blockIdx.x), G(gridDim.x),
        gw(blockIdx.x * 8 + wave), NGW(gridDim.x * 8), gtid(blockIdx.x * 512 + threadIdx.x), GT(gridDim.x * 512) {}
};

__device__ __forceinline__ void phase0(const Ctx& c) {
    const float* x = c.a.in[0];
    bf16_t* xb = (bf16_t*)(c.a.ws + WS_XB);
    for (size_t i0 = c.gtid; i0 < (size_t)NTOK * DM / 8; i0 += (size_t)4 * c.GT) {
        f32x4 p[4], q[4];
#pragma unroll
        for (int u = 0; u < 4; ++u) { const size_t i = i0 + (size_t)u * c.GT; p[u] = __builtin_nontemporal_load((const f32x4*)x + 2 * i); q[u] = __builtin_nontemporal_load((const f32x4*)x + 2 * i + 1); }
#pragma unroll
        for (int u = 0; u < 4; ++u) { const size_t i = i0 + (size_t)u * c.GT;
            u32x4 o; o.x = cvt_pk_bf16(p[u][0], p[u][1]); o.y = cvt_pk_bf16(p[u][2], p[u][3]); o.z = cvt_pk_bf16(q[u][0], q[u][1]); o.w = cvt_pk_bf16(q[u][2], q[u][3]); ((u32x4*)xb)[i] = o; } }
    LAS float* scr = (LAS float*)(c.lds + c.wave * 16384);
    bf16_t* wint = (bf16_t*)(c.a.ws + WS_WINT);
    for (int it = c.gw; it < 32 * 175; it += c.NGW) tr_item<0>(c.a.in[1], DM, 5600, wint, DM, scr, it, c.lane);
    for (int i = c.gtid; i < 32 * DM / 8; i += c.GT) ((u32x4*)(wint + (size_t)5600 * DM))[i] = (u32x4){0u, 0u, 0u, 0u};
}

__device__ __forceinline__ void phase2(const Ctx& c) {
    const bf16_t* proj = (const bf16_t*)(c.a.ws + WS_PROJ);
    bf16_t* al = (bf16_t*)((unsigned char*)c.a.out + DO_ALORA);
    const float* mu = c.a.in[2];
    for (int i = c.gtid; i < NTOK * 64; i += c.GT) { const int tok = i >> 6, g = i & 63, t = tok & (SEQ - 1);
        u32x4 w = {0u, 0u, 0u, 0u};
        if (g < 60) { const int col = (g < 32) ? (5344 + 8 * g) : (G_OFF + 8 * (g - 32));
            const bf16_t* p0 = proj + (size_t)tok * INP + col; const bf16_t* pp = t > 0 ? p0 - INP : p0; const bf16_t* pn = t < SEQ - 1 ? p0 + INP : p0;
            const float fp = t > 0 ? 1.0f : 0.0f, fn = t < SEQ - 1 ? 1.0f : 0.0f;
            float x0[8], x1[8], x2[8], o[8];
            { const u32x4 w0 = *(const u32x4*)p0, w1 = *(const u32x4*)pp, w2 = *(const u32x4*)pn;
#pragma unroll
              for (int e = 0; e < 4; ++e) { x0[2 * e] = __uint_as_float(w0[e] << 16); x0[2 * e + 1] = __uint_as_float(w0[e] & 0xffff0000u); x1[2 * e] = __uint_as_float(w1[e] << 16); x1[2 * e + 1] = __uint_as_float(w1[e] & 0xffff0000u);
                  x2[2 * e] = __uint_as_float(w2[e] << 16); x2[2 * e + 1] = __uint_as_float(w2[e] & 0xffff0000u); } }
            const f32x4 m0 = *(const f32x4*)(mu + col - 512), m1 = *(const f32x4*)(mu + col - 512 + 4);
#pragma unroll
            for (int e = 0; e < 8; ++e) { const float s = x0[e] + (0.5f * (x1[e] * fp + x2[e] * fn) - x0[e]) * (e < 4 ? m0[e] : m1[e - 4]);
                o[e] = (g < 16) ? (1.0f - 2.0f * __builtin_amdgcn_rcpf(1.0f + __expf(2.0f * s))) : (g < 32) ? s : sigmoidf_(s); }
            w.x = cvt_pk_bf16(o[0], o[1]); w.y = cvt_pk_bf16(o[2], o[3]); w.z = cvt_pk_bf16(o[4], o[5]); w.w = cvt_pk_bf16(o[6], o[7]); }
        ((u32x4*)al)[i] = w; }
}
__device__ __forceinline__ void phase1_fill(const Args& a, LAS unsigned char* lds, int idx, int n) {
    const int lane = threadIdx.x & 63, wave = __builtin_amdgcn_readfirstlane(threadIdx.x >> 6), gtid = idx * 512 + threadIdx.x, GT = n * 512, gw = idx * 8 + wave, NGW = n * 8;
    LAS float* T = (LAS float*)(lds + 131072);
    for (int m = threadIdx.x; m < 2048; m += 512) T[m] = cospif((float)m * (1.0f / 1024.0f)) * 0.022097086912079608f;
    __syncthreads();
    bf16_t* dm = (bf16_t*)(a.ws + WS_DFTM);
    for (int i = gtid; i < 2048 * 4096 / 8; i += GT) { const int sp = i >> 9, k0 = (i & 511) * 8; float v[8];
#pragma unroll
        for (int j = 0; j < 8; ++j) { const int k = k0 + j; v[j] = T[(sp * (k & 2047) + (k < 2048 ? 0 : 512)) & 2047]; }
        u32x4 o; o.x = cvt_pk_bf16(v[0], v[1]); o.y = cvt_pk_bf16(v[2], v[3]); o.z = cvt_pk_bf16(v[4], v[5]); o.w = cvt_pk_bf16(v[6], v[7]); ((u32x4*)dm)[i] = o; }
    __syncthreads();
    bf16_t* wlt = (bf16_t*)(a.ws + WS_WLT);
    for (int i = gtid; i < 6144 * 128; i += GT) { const int n = i >> 7, k = i & 127, q = n / RW, ch = n % RW; float v = 0.f;
        if ((k >> 6) == (q & 1)) { const float* up = (q == 0) ? a.in[3] : (q == 1) ? a.in[4] : (q == 2) ? a.in[7] : a.in[8]; v = up[(size_t)(k & 63) * RW + ch]; }
        wlt[i] = f2bf(v); }
    bf16_t* wgt = (bf16_t*)(a.ws + WS_WLT + 2 * MiB);
    for (int i = gtid; i < 1536 * 256; i += GT) { const int ch = i >> 8, k = i & 255; wgt[i] = f2bf(k < 224 ? a.in[11][(size_t)k * RW + ch] : 0.f); }
    { float* bs = (float*)(a.ws + WS_BIAS);
      for (int i = gtid; i < RW; i += GT) { bs[i] = a.in[5][i]; bs[RW + i] = a.in[6][i]; bs[2 * RW + i] = a.in[9][i]; bs[3 * RW + i] = a.in[10][i]; } }
    bf16_t* cd = (bf16_t*)(a.ws + WS_CDFT);
    for (int i = gtid; i < 1024 * 512; i += GT) { const int m = i >> 9, k = i & 511, part = m >> 9, g = (m >> 7) & 3, cp = m & 127, g2 = k >> 7, cc = k & 127; float v = 0.f;
        if (g == g2) { const float ang = (float)((cc * cp) & 127) * (1.0f / 64.0f); v = (part ? sinpif(ang) : cospif(ang)) * 0.08838834764831845f; }
        cd[i] = f2bf(v); }
    LAS float* scr = (LAS float*)(lds + wave * 16384);
    for (int it = gw; it < 32 * 64; it += NGW) tr_item<0>(a.in[17], DM, DM, (bf16_t*)(a.ws + WS_WOUTT), DM, scr, it, lane);
}

typedef short bf16x4 __attribute__((ext_vector_type(4)));
constexpr int YBUF = 64 * 144;
constexpr int RS = 136, RS2 = 40;
constexpr int SL_AT = 0, SL_RT = 2176, SL_BT = 4352, SL_TT = 4352, SL_KT = 6528, SL_BH = 8704, SL_KH = 11264, SL_V = 13824, SL_WT = 16384, SLOT = 16640;
__device__ __forceinline__ bf16x4 cvt4(const f32x4 v) { u32x2 w; w.x = cvt_pk_bf16(v[0], v[1]); w.y = cvt_pk_bf16(v[2], v[3]); return __builtin_bit_cast(bf16x4, w); }
__device__ __forceinline__ bf16x8 cat8(const bf16x4 lo, const bf16x4 hi) { return __builtin_shufflevector(lo, hi, 0, 1, 2, 3, 4, 5, 6, 7); }
__device__ __forceinline__ f32x4 mfma16(const bf16x4 a, const bf16x4 b, const f32x4 c) { return __builtin_amdgcn_mfma_f32_16x16x16bf16_1k(a, b, c, 0, 0, 0); }
__device__ __forceinline__ f32x4 mfma32(const bf16x8 a, const bf16x8 b, const f32x4 c) { return __builtin_amdgcn_mfma_f32_16x16x32_bf16(a, b, c, 0, 0, 0); }

__device__ __forceinline__ void scan2_phase(const Args& a, LAS unsigned char* lds) {
    const int bid = blockIdx.x; if (bid >= 192) return;
    const int lane = threadIdx.x & 63, wave = __builtin_amdgcn_readfirstlane(threadIdx.x >> 6), dir = wave >> 2, ws = wave & 3;
    const int b = bid / NH, h = bid % NH, ch = h * 64 + lane, fr = lane & 15, g = lane >> 4, i0 = 16 * ws;
    LAS unsigned char* base = lds + dir * (4 * SLOT);
    const float kk_ = a.in[12][ch], ka_ = a.in[13][ch];
    const float mur = a.in[2][R_OFF - 512 + ch], muk = a.in[2][K_OFF - 512 + ch], muv = a.in[2][V_OFF - 512 + ch];
    const unsigned char* P = a.ws + WS_PROJ + (size_t)b * SEQ * INP * 2;
    const unsigned char* LW = a.ws + WS_OUT5 + ((size_t)dir * OUT5_STRIDE + (size_t)b * SEQ * RW) * 2;
    const unsigned char* AI = a.ws + WS_OUT5 + ((size_t)(2 + dir) * OUT5_STRIDE + (size_t)b * SEQ * RW) * 2;
    const unsigned voK = (unsigned)(K_OFF + ch) * 2u, voC = (unsigned)ch * 2u;
    const long sP = dir ? -(long)(INP * 2) : (long)(INP * 2), sL = dir ? -(long)(RW * 2) : (long)(RW * 2);
    bf16_t* Y = (bf16_t*)((unsigned char*)a.out + DO_Y) + (size_t)b * SEQ * RW + h * 64;
    LAS unsigned char* ybuf = lds + 8 * SLOT + dir * YBUF;
    f32x4 St[4];
#pragma unroll
    for (int jt = 0; jt < 4; ++jt) St[jt] = (f32x4){0.f, 0.f, 0.f, 0.f};
    unsigned rru[18], kru[18], vru[18], lwu[16], aiu[16];
#define LDU16(base, boff) ((unsigned)(*(const bf16_t*)((base) + (boff))))
#define SCAN_LOAD_RAW(cidx) do { \
        const int t0_ = dir ? (SEQ - 16 * (cidx)) : (16 * (cidx) - 1), l0_ = dir ? (SEQ - 1 - 16 * (cidx)) : (16 * (cidx)); \
        const unsigned char* bP_ = P + (long)t0_ * (INP * 2); const unsigned char* bL_ = LW + (long)l0_ * (RW * 2); const unsigned char* bA_ = AI + (long)l0_ * (RW * 2); \
        _Pragma("unroll") for (int i = 0; i < 18; ++i) { const unsigned char* rb = bP_ + sP * i; \
            rru[i] = LDU16(rb, voK - (K_OFF - R_OFF) * 2); kru[i] = LDU16(rb, voK); vru[i] = LDU16(rb, voK + (V_OFF - K_OFF) * 2); } \
        _Pragma("unroll") for (int i = 0; i < 16; ++i) { lwu[i] = LDU16(bL_ + sL * i, voC); aiu[i] = LDU16(bA_ + sL * i, voC); } } while (0)
    SCAN_LOAD_RAW(ws);
    for (int G = 0; G < SEQ / 64; ++G) {
        LAS unsigned char* slot = base + ws * SLOT;
        {
            float rr[18], kr[18], vr[18], lwv[16], aiv[16];
            { const int cidx = 4 * G + ws;
#pragma unroll
              for (int i = 0; i < 18; ++i) { const unsigned m = (i == 0) ? ((cidx == 0) ? 0u : 0xffffffffu) : (i == 17) ? ((cidx == SEQ / 16 - 1) ? 0u : 0xffffffffu) : 0xffffffffu;
                  rr[i] = __uint_as_float((rru[i] << 16) & m); kr[i] = __uint_as_float((kru[i] << 16) & m); vr[i] = __uint_as_float((vru[i] << 16) & m); }
#pragma unroll
              for (int i = 0; i < 16; ++i) { lwv[i] = __uint_as_float(lwu[i] << 16); aiv[i] = __uint_as_float(aiu[i] << 16); } }
            float E[17], Ei[16]; E[0] = 1.0f;
            { float Lc = 0.f;
#pragma unroll
              for (int tt = 0; tt < 16; ++tt) { Lc += lwv[tt] * 1.4426950408889634f; E[tt + 1] = __builtin_amdgcn_exp2f(Lc); Ei[tt] = __builtin_amdgcn_exp2f(-Lc); } }
            const float ET = E[16];
            float bh[16], kh[16], vv[16], inv[16];
            {
                float sq[16];
#pragma unroll
                for (int tt = 0; tt < 16; ++tt) { const float kq = (kr[tt + 1] + (0.5f * (kr[tt] + kr[tt + 2]) - kr[tt + 1]) * muk) * kk_; sq[tt] = kq * kq; }
#define DPP_STAGE(ctrl, rmask, bc) _Pragma("unroll") for (int tt = 0; tt < 16; ++tt) sq[tt] += __builtin_bit_cast(float, __builtin_amdgcn_update_dpp(0, __builtin_bit_cast(int, sq[tt]), ctrl, rmask, 0xf, bc));
                DPP_STAGE(0xB1, 0xf, true) DPP_STAGE(0x4E, 0xf, true) DPP_STAGE(0x141, 0xf, true) DPP_STAGE(0x140, 0xf, true) DPP_STAGE(0x142, 0xa, false) DPP_STAGE(0x143, 0xc, false)
#undef DPP_STAGE
#pragma unroll
                for (int tt = 0; tt < 16; ++tt) inv[tt] = rsqrtf(fmaxf(__builtin_bit_cast(float, __builtin_amdgcn_readlane(__builtin_bit_cast(int, sq[tt]), 63)), 1e-24f));
            }
#pragma unroll
            for (int tp = 0; tp < 16; tp += 2) {
                float av[2], bv[2], kv[2], rv[2];
#pragma unroll
                for (int u = 0; u < 2; ++u) { const int tt = tp + u;
                    const float r = rr[tt + 1] + (0.5f * (rr[tt] + rr[tt + 2]) - rr[tt + 1]) * mur;
                    const float k = kr[tt + 1] + (0.5f * (kr[tt] + kr[tt + 2]) - kr[tt + 1]) * muk;
                    const float v = vr[tt + 1] + (0.5f * (vr[tt] + vr[tt + 2]) - vr[tt + 1]) * muv;
                    const float ai = aiv[tt];
                    const float kk = k * kk_ * inv[tt];
                    const float kd = k * (1.0f + (ai - 1.0f) * ka_);
                    const float bt = kk * ai * Ei[tt], kt = kd * Ei[tt];
                    av[u] = -kk * E[tt]; bv[u] = bt; kv[u] = kt; rv[u] = r * E[tt + 1];
                    bh[tt] = bt * ET; kh[tt] = kt * ET; vv[tt] = v; }
                const unsigned wa = cvt_pk_bf16(av[0], av[1]), wb = cvt_pk_bf16(bv[0], bv[1]), wk = cvt_pk_bf16(kv[0], kv[1]), wr_ = cvt_pk_bf16(rv[0], rv[1]);
                *(LAS bf16_t*)(slot + SL_AT + tp * RS + lane * 2) = (bf16_t)(wa & 0xffffu); *(LAS bf16_t*)(slot + SL_AT + (tp + 1) * RS + lane * 2) = (bf16_t)(wa >> 16);
                *(LAS bf16_t*)(slot + SL_BT + tp * RS + lane * 2) = (bf16_t)(wb & 0xffffu); *(LAS bf16_t*)(slot + SL_BT + (tp + 1) * RS + lane * 2) = (bf16_t)(wb >> 16);
                *(LAS bf16_t*)(slot + SL_KT + tp * RS + lane * 2) = (bf16_t)(wk & 0xffffu); *(LAS bf16_t*)(slot + SL_KT + (tp + 1) * RS + lane * 2) = (bf16_t)(wk >> 16);
                *(LAS bf16_t*)(slot + SL_RT + tp * RS + lane * 2) = (bf16_t)(wr_ & 0xffffu); *(LAS bf16_t*)(slot + SL_RT + (tp + 1) * RS + lane * 2) = (bf16_t)(wr_ >> 16);
            }
#pragma unroll
            for (int q = 0; q < 4; ++q) { u32x2 w0, w1, w2;
                w0.x = cvt_pk_bf16(bh[4 * q + 0], bh[4 * q + 1]); w0.y = cvt_pk_bf16(bh[4 * q + 2], bh[4 * q + 3]);
                w1.x = cvt_pk_bf16(kh[4 * q + 0], kh[4 * q + 1]); w1.y = cvt_pk_bf16(kh[4 * q + 2], kh[4 * q + 3]);
                w2.x = cvt_pk_bf16(vv[4 * q + 0], vv[4 * q + 1]); w2.y = cvt_pk_bf16(vv[4 * q + 2], vv[4 * q + 3]);
                *(LAS u32x2*)(slot + SL_BH + lane * RS2 + q * 8) = w0; *(LAS u32x2*)(slot + SL_KH + lane * RS2 + q * 8) = w1; *(LAS u32x2*)(slot + SL_V + lane * RS2 + q * 8) = w2; }
            *(LAS float*)(slot + SL_WT + lane * 4) = ET;
        }
        if (G + 1 < SEQ / 64) SCAN_LOAD_RAW(4 * (G + 1) + ws);
        LDS_WAIT(); __builtin_amdgcn_wave_barrier();
        {
            bf16x8 fa[2], fb[2], fk[2], frr[2];
#pragma unroll
            for (int m = 0; m < 2; ++m) { const int off = fr * RS + (32 * m + 8 * g) * 2;
                fa[m] = cat8(*(const LAS bf16x4*)(slot + SL_AT + off), *(const LAS bf16x4*)(slot + SL_AT + off + 8)); fb[m] = cat8(*(const LAS bf16x4*)(slot + SL_BT + off), *(const LAS bf16x4*)(slot + SL_BT + off + 8));
                fk[m] = cat8(*(const LAS bf16x4*)(slot + SL_KT + off), *(const LAS bf16x4*)(slot + SL_KT + off + 8)); frr[m] = cat8(*(const LAS bf16x4*)(slot + SL_RT + off), *(const LAS bf16x4*)(slot + SL_RT + off + 8)); }
            const f32x4 z4 = {0.f, 0.f, 0.f, 0.f};
            f32x4 aP = mfma32(fa[1], fb[1], mfma32(fa[0], fb[0], z4));
            f32x4 aPT = mfma32(fb[1], fa[1], mfma32(fb[0], fa[0], z4));
            f32x4 aKa = mfma32(fk[1], fa[1], mfma32(fk[0], fa[0], z4));
            f32x4 aBr = mfma32(fb[1], frr[1], mfma32(fb[0], frr[0], z4));
            f32x4 aKr = mfma32(fk[1], frr[1], mfma32(fk[0], frr[0], z4));
            f32x4 aU;
#pragma unroll
            for (int jj = 0; jj < 4; ++jj) { const int rw = 4 * g + jj;
                aP[jj] = (fr < rw) ? aP[jj] : 0.f; aPT[jj] = (rw < fr) ? aPT[jj] : 0.f; aKa[jj] = (rw < fr) ? aKa[jj] : 0.f;
                aBr[jj] = (rw <= fr) ? aBr[jj] : 0.f; aKr[jj] = (rw <= fr) ? aKr[jj] : 0.f; aU[jj] = aPT[jj] + ((rw == fr) ? 1.0f : 0.f); }
            const bf16x4 pP = cvt4(aP), pPT = cvt4(aPT);
            const f32x4 aP2 = mfma16(pPT, pP, z4), aPT2 = mfma16(pP, pPT, z4);
            const bf16x4 pP2 = cvt4(aP2), pPT2 = cvt4(aPT2);
            aU = mfma16(pP2, cvt4(aU), aU);
            const f32x4 aP4 = mfma16(pPT2, pP2, z4), aPT4 = mfma16(pP2, pPT2, z4);
            const bf16x4 pP4 = cvt4(aP4), pPT4 = cvt4(aPT4);
            aU = mfma16(pP4, cvt4(aU), aU);
            const f32x4 aP8 = mfma16(pPT4, pP4, z4);
            aU = mfma16(cvt4(aP8), cvt4(aU), aU);
            *(LAS bf16x4*)(slot + SL_TT + 0 * 512 + lane * 8) = cvt4(aU);
            *(LAS bf16x4*)(slot + SL_TT + 1 * 512 + lane * 8) = cvt4(aKa);
            *(LAS bf16x4*)(slot + SL_TT + 2 * 512 + lane * 8) = cvt4(aBr);
            *(LAS bf16x4*)(slot + SL_TT + 3 * 512 + lane * 8) = cvt4(aKr);
        }
        RAW_BARRIER();
        for (int cc = 0; cc < 4; ++cc) {
            const LAS unsigned char* sl = base + cc * SLOT;
            bf16x8 Af[2], Rf[2], BK[4]; f32x4 wt[4];
#pragma unroll
            for (int m = 0; m < 2; ++m) { const int off = fr * RS + (32 * m + 4 * g) * 2;
                Af[m] = cat8(*(const LAS bf16x4*)(sl + SL_AT + off), *(const LAS bf16x4*)(sl + SL_AT + off + 32));
                Rf[m] = cat8(*(const LAS bf16x4*)(sl + SL_RT + off), *(const LAS bf16x4*)(sl + SL_RT + off + 32)); }
#pragma unroll
            for (int jt = 0; jt < 4; ++jt) { const int off = (16 * jt + fr) * RS2 + 8 * g;
                BK[jt] = cat8(*(const LAS bf16x4*)(sl + SL_BH + off), *(const LAS bf16x4*)(sl + SL_KH + off));
                wt[jt] = *(const LAS f32x4*)(sl + SL_WT + (16 * jt + 4 * g) * 4); }
            const bf16x4 tU = *(const LAS bf16x4*)(sl + SL_TT + 0 * 512 + lane * 8), tKa = *(const LAS bf16x4*)(sl + SL_TT + 1 * 512 + lane * 8);
            const bf16x4 tBr = *(const LAS bf16x4*)(sl + SL_TT + 2 * 512 + lane * 8), tKr = *(const LAS bf16x4*)(sl + SL_TT + 3 * 512 + lane * 8);
            const bf16x4 Vf = *(const LAS bf16x4*)(sl + SL_V + (i0 + fr) * RS2 + 8 * g);
            const bf16x8 B01 = cat8(cvt4(St[0]), cvt4(St[1])), B23 = cat8(cvt4(St[2]), cvt4(St[3]));
            const f32x4 z4 = {0.f, 0.f, 0.f, 0.f};
            f32x4 X = mfma32(Af[0], B01, z4); X = mfma32(Af[1], B23, X); X = mfma16(tKa, Vf, X);
            const f32x4 SA = mfma16(tU, cvt4(X), z4);
            const bf16x8 BSV = cat8(cvt4(SA), Vf);
            f32x4 Yv = mfma32(Rf[0], B01, z4); Yv = mfma32(Rf[1], B23, Yv); Yv = mfma32(cat8(tBr, tKr), BSV, Yv);
#pragma unroll
            for (int jt = 0; jt < 4; ++jt) St[jt] = mfma32(BK[jt], BSV, St[jt] * wt[jt]);
#pragma unroll
            for (int jj = 0; jj < 4; ++jj) *(LAS bf16_t*)(ybuf + (16 * cc + 4 * g + jj) * 144 + (i0 + fr) * 2) = f2bf(Yv[jj]);
        }
        RAW_BARRIER();
#pragma unroll
        for (int q = 0; q < 2; ++q) { const int tl = 16 * ws + (lane >> 3) + 8 * q, tau = 64 * G + tl, t = dir ? (SEQ - 1 - tau) : tau;
            u32x4* yp = (u32x4*)(Y + (size_t)t * RW + (lane & 7) * 8);
            u32x4 w = *(const LAS u32x4*)(ybuf + tl * 144 + (lane & 7) * 16);
            if (G >= SEQ / 128) { const u32x4 o = *yp;
#pragma unroll
                for (int e = 0; e < 4; ++e) w[e] = cvt_pk_bf16(__uint_as_float(w[e] << 16) + __uint_as_float(o[e] << 16), __uint_as_float(w[e] & 0xffff0000u) + __uint_as_float(o[e] & 0xffff0000u)); }
            *yp = w; }
        if (G == SEQ / 128 - 1) { asm volatile("s_waitcnt vmcnt(0)" ::: "memory"); RAW_BARRIER(); }
    }
    RAW_BARRIER();
#undef SCAN_LOAD_RAW
#undef LDU16
}

__device__ __forceinline__ void unpack8(const u32x4 w, float (&f)[8]) {
#pragma unroll
    for (int i = 0; i < 4; ++i) { f[2 * i] = __uint_as_float(w[i] << 16); f[2 * i + 1] = __uint_as_float(w[i] & 0xffff0000u); }
}
__device__ __forceinline__ float sum8lanes(float v) {
    v += __builtin_bit_cast(float, __builtin_amdgcn_update_dpp(0, __builtin_bit_cast(int, v), 0xB1, 0xf, 0xf, true));
    v += __builtin_bit_cast(float, __builtin_amdgcn_update_dpp(0, __builtin_bit_cast(int, v), 0x4E, 0xf, 0xf, true));
    v += __builtin_bit_cast(float, __builtin_amdgcn_update_dpp(0, __builtin_bit_cast(int, v), 0x141, 0xf, 0xf, true));
    return v; }
__device__ __forceinline__ void post_phase(const Ctx& c) {
    if (c.gw >= 2046) return;
    const int third = c.gw % 3, cb = third * 512 + c.lane * 8;
    const bf16_t* proj = (const bf16_t*)(c.a.ws + WS_PROJ);
    const bf16_t* o5 = (const bf16_t*)(c.a.ws + WS_OUT5);
    const bf16_t* yy = (const bf16_t*)((unsigned char*)c.a.out + DO_Y);
    bf16_t* amix = (bf16_t*)(c.a.ws + WS_AMIX);
    float mur[8], muk[8], muv[8], lg[8], lb[8], ka[8], rk[8];
#pragma unroll
    for (int e = 0; e < 8; ++e) { mur[e] = c.a.in[2][R_OFF - 512 + cb + e]; muk[e] = c.a.in[2][K_OFF - 512 + cb + e]; muv[e] = c.a.in[2][V_OFF - 512 + cb + e];
        lg[e] = c.a.in[15][cb + e]; lb[e] = c.a.in[16][cb + e]; ka[e] = c.a.in[13][cb + e]; rk[e] = c.a.in[14][cb + e]; }
    for (int tok = c.gw / 3; tok < NTOK; tok += 682) {
        const int t = tok & (SEQ - 1);
        const float fp = t > 0 ? 1.0f : 0.0f, fn = t < SEQ - 1 ? 1.0f : 0.0f;
        const bf16_t* p0 = proj + (size_t)tok * INP + cb; const bf16_t* pp = t > 0 ? p0 - INP : p0; const bf16_t* pn = t < SEQ - 1 ? p0 + INP : p0;
        const u32x4 wr0 = *(const u32x4*)(p0 + R_OFF), wrp = *(const u32x4*)(pp + R_OFF), wrn = *(const u32x4*)(pn + R_OFF);
        const u32x4 wk0 = *(const u32x4*)(p0 + K_OFF), wkp = *(const u32x4*)(pp + K_OFF), wkn = *(const u32x4*)(pn + K_OFF);
        const u32x4 wv0 = *(const u32x4*)(p0 + V_OFF), wvp = *(const u32x4*)(pp + V_OFF), wvn = *(const u32x4*)(pn + V_OFF);
        const size_t e0 = (size_t)tok * RW + cb;
        const u32x4 wyy = __builtin_nontemporal_load((const u32x4*)(yy + e0)), waf = __builtin_nontemporal_load((const u32x4*)(o5 + 2 * OUT5_STRIDE + e0)), wab = __builtin_nontemporal_load((const u32x4*)(o5 + 3 * OUT5_STRIDE + e0)), wg = __builtin_nontemporal_load((const u32x4*)(o5 + 4 * OUT5_STRIDE + e0));
        float r[8], k[8], v[8], y[8], x0[8], x1[8], x2[8];
        unpack8(wr0, x0); unpack8(wrp, x1); unpack8(wrn, x2);
#pragma unroll
        for (int e = 0; e < 8; ++e) r[e] = x0[e] + (0.5f * (x1[e] * fp + x2[e] * fn) - x0[e]) * mur[e];
        unpack8(wk0, x0); unpack8(wkp, x1); unpack8(wkn, x2);
#pragma unroll
        for (int e = 0; e < 8; ++e) k[e] = x0[e] + (0.5f * (x1[e] * fp + x2[e] * fn) - x0[e]) * muk[e];
        unpack8(wv0, x0); unpack8(wvp, x1); unpack8(wvn, x2);
#pragma unroll
        for (int e = 0; e < 8; ++e) v[e] = x0[e] + (0.5f * (x1[e] * fp + x2[e] * fn) - x0[e]) * muv[e];
        unpack8(wyy, y);
        float s = 0.f;
#pragma unroll
        for (int e = 0; e < 8; ++e) s += y[e];
        const float m = sum8lanes(s) * (1.0f / 64.0f);
        float s2 = 0.f;
#pragma unroll
        for (int e = 0; e < 8; ++e) { y[e] -= m; s2 += y[e] * y[e]; }
        const float rstd = rsqrtf(sum8lanes(s2) * (1.0f / 64.0f) + GN_EPS);
        unpack8(waf, x0); unpack8(wab, x1); unpack8(wg, x2);
        float bs = 0.f;
#pragma unroll
        for (int e = 0; e < 8; ++e) bs += r[e] * k[e] * (2.0f + (x0[e] + x1[e] - 2.0f) * ka[e]) * rk[e];
        const float bon = sum8lanes(bs);
        float o[8];
#pragma unroll
        for (int e = 0; e < 8; ++e) o[e] = (y[e] * rstd * lg[e] + lb[e] + bon * v[e]) * x2[e];
        u32x4 w; w.x = cvt_pk_bf16(o[0], o[1]); w.y = cvt_pk_bf16(o[2], o[3]); w.z = cvt_pk_bf16(o[4], o[5]); w.w = cvt_pk_bf16(o[6], o[7]);
        *(u32x4*)(amix + (size_t)tok * DM + 512 + cb) = w;
    }
}

__device__ __forceinline__ void ln_phase(const Ctx& c, float* Z, bf16_t* ZB, const float* g, const float* bta, float* O) {
    for (int row0 = c.gw; row0 < NTOK; row0 += 2 * c.NGW) {
        f32x4 v[2][8]; float s[2] = {0.f, 0.f};
#pragma unroll
        for (int u = 0; u < 2; ++u) { const f32x4* zr = (const f32x4*)(Z + (size_t)(row0 + u * c.NGW) * DM) + c.lane;
#pragma unroll
            for (int j = 0; j < 8; ++j) v[u][j] = zr[64 * j]; }
#pragma unroll
        for (int u = 0; u < 2; ++u)
#pragma unroll
            for (int j = 0; j < 8; ++j) s[u] += (v[u][j][0] + v[u][j][1]) + (v[u][j][2] + v[u][j][3]);
        float mean[2], s2[2] = {0.f, 0.f}, rstd[2];
#pragma unroll
        for (int u = 0; u < 2; ++u) mean[u] = wave_sum(s[u]) * (1.0f / DM);
#pragma unroll
        for (int u = 0; u < 2; ++u)
#pragma unroll
            for (int j = 0; j < 8; ++j) { v[u][j] = v[u][j] - mean[u]; s2[u] += (v[u][j][0] * v[u][j][0] + v[u][j][1] * v[u][j][1]) + (v[u][j][2] * v[u][j][2] + v[u][j][3] * v[u][j][3]); }
#pragma unroll
        for (int u = 0; u < 2; ++u) rstd[u] = rsqrtf(wave_sum(s2[u]) * (1.0f / DM) + LN_EPS);
#pragma unroll
        for (int j = 0; j < 8; ++j) { const f32x4 gg = ((const f32x4*)g)[c.lane + 64 * j], bb = ((const f32x4*)bta)[c.lane + 64 * j];
#pragma unroll
            for (int u = 0; u < 2; ++u) { const size_t row = (size_t)(row0 + u * c.NGW);
                const f32x4 o = v[u][j] * rstd[u] * gg + bb;
                if (O) ((f32x4*)(O + row * DM))[c.lane + 64 * j] = o;
                if (ZB) { u32x2 w; w.x = cvt_pk_bf16(o[0], o[1]); w.y = cvt_pk_bf16(o[2], o[3]); ((u32x2*)(ZB + row * DM))[c.lane + 64 * j] = w; } } }
    }
}


#define XB_TMO      128
#define XB_XCNT(j)  (256  + 64 * (j))
#define XB_XSUB(j)  (1280 + 64 * (j))
#define XB_XGEN(j)  (2304 + 64 * (j))
#define XB_TOP      3328
#define XB_TOPGEN   3392
#define XCD_BAR_WORDS 3456
#define XB_SPIN_CAP (1u << 18)
__device__ __forceinline__ unsigned xb_ld(unsigned* p)              { return __hip_atomic_load(p, __ATOMIC_RELAXED, __HIP_MEMORY_SCOPE_AGENT); }
__device__ __forceinline__ unsigned xb_add(unsigned* p, unsigned v) { return __hip_atomic_fetch_add(p, v, __ATOMIC_RELAXED, __HIP_MEMORY_SCOPE_AGENT); }
__device__ __forceinline__ unsigned xb_xcc_id() { return (unsigned)__builtin_amdgcn_s_getreg((3 << 11) | 20) & 0xFu; }
#define XB_SPIN(cond, bar) do { unsigned _sp = 0; while (cond) { __builtin_amdgcn_s_sleep(1); \
    if ((++_sp & 255u) == 0u) { if (xb_ld(&(bar)[XB_TMO])) break; if (_sp > XB_SPIN_CAP) { atomicAdd(&(bar)[XB_TMO], 1u); break; } } } } while (0)
struct XcdBarrier { unsigned* bar; unsigned x; volatile LAS unsigned* st; };
__device__ __forceinline__ XcdBarrier xcd_barrier_post(unsigned* bar, volatile LAS unsigned* st) {
    XcdBarrier b; b.bar = bar; b.x = xb_xcc_id(); b.st = st;
    if (threadIdx.x == 0) (void)xb_add(&bar[XB_XCNT(b.x)], 1u);
    return b;
}
__device__ __forceinline__ void xcd_barrier_complete(unsigned* bar, unsigned x, unsigned& nloc, unsigned& nx) {
    const unsigned G = gridDim.x * gridDim.y * gridDim.z;
    unsigned sum, cnt, mine, sp = 0u;
    for (;;) {
        sum = 0u; cnt = 0u; mine = 0u;
#pragma unroll
        for (unsigned j = 0; j < 16; ++j) { const unsigned c = xb_ld(&bar[XB_XCNT(j)]); sum += c; cnt += (c > 0u) ? 1u : 0u; mine = (j == x) ? c : mine; }
        if (sum == G) break;
        __builtin_amdgcn_s_sleep(1);
        if ((++sp & 255u) == 0u) { if (xb_ld(&bar[XB_TMO])) break; if (sp > XB_SPIN_CAP) { atomicAdd(&bar[XB_TMO], 1u); break; } }
    }
    nloc = mine > 0u ? mine : 1u; nx = cnt > 0u ? cnt : 1u;
}
__device__ __forceinline__ void xcd_barrier(const XcdBarrier& b) {
    asm volatile("s_waitcnt vmcnt(0)" ::: "memory");
    __syncthreads();
    if (threadIdx.x == 0) {
        unsigned* bar = b.bar;
        __builtin_amdgcn_s_waitcnt(0);
        unsigned nloc = b.st[0], nx = b.st[1];
        if (nloc == 0u) { xcd_barrier_complete(bar, b.x, nloc, nx); b.st[0] = nloc; b.st[1] = nx; }
        const unsigned old = xb_add(&bar[XB_XSUB(b.x)], 1u);
        const unsigned gen = old / nloc;
        if (old + 1u == (gen + 1u) * nloc) {
            __builtin_amdgcn_fence(__ATOMIC_RELEASE, "agent");
            asm volatile("s_waitcnt vmcnt(0)" ::: "memory");
            const unsigned og = xb_add(&bar[XB_TOP], 1u);
            const unsigned tg = og / nx;
            if (og + 1u == (tg + 1u) * nx) xb_add(&bar[XB_TOPGEN], 1u);
            else XB_SPIN(xb_ld(&bar[XB_TOPGEN]) == tg, bar);
            __builtin_amdgcn_fence(__ATOMIC_ACQUIRE, "agent");
            xb_add(&bar[XB_XGEN(b.x)], 1u);
            asm volatile("s_waitcnt vmcnt(0)" ::: "memory");
        } else {
            XB_SPIN(xb_ld(&bar[XB_XGEN(b.x)]) == gen, bar);
            __builtin_amdgcn_fence(__ATOMIC_ACQUIRE, "agent");
            asm volatile("s_waitcnt vmcnt(0)" ::: "memory");
        }
    }
    __syncthreads();
}

template <bool OUT_F32> __device__ __forceinline__ void ln_bf16_phase(const Ctx& c, const bf16_t* Z, void* Ov, const float* g, const float* bta) {
    for (int row0 = c.gw; row0 < NTOK; row0 += 2 * c.NGW) {
        float v[2][32]; float s[2] = {0.f, 0.f};
#pragma unroll
        for (int u = 0; u < 2; ++u) { const u32x4* zr = (const u32x4*)(Z + (size_t)(row0 + u * c.NGW) * DM) + c.lane;
#pragma unroll
            for (int j = 0; j < 4; ++j) { const u32x4 w = __builtin_nontemporal_load(zr + 64 * j);
#pragma unroll
                for (int e = 0; e < 4; ++e) { v[u][8 * j + 2 * e] = __uint_as_float(w[e] << 16); v[u][8 * j + 2 * e + 1] = __uint_as_float(w[e] & 0xffff0000u); } } }
#pragma unroll
        for (int u = 0; u < 2; ++u)
#pragma unroll
            for (int e = 0; e < 32; ++e) s[u] += v[u][e];
        float mean[2], s2[2] = {0.f, 0.f}, rstd[2];
#pragma unroll
        for (int u = 0; u < 2; ++u) mean[u] = wave_sum_dpp(s[u]) * (1.0f / DM);
#pragma unroll
        for (int u = 0; u < 2; ++u)
#pragma unroll
            for (int e = 0; e < 32; ++e) { v[u][e] -= mean[u]; s2[u] += v[u][e] * v[u][e]; }
#pragma unroll
        for (int u = 0; u < 2; ++u) rstd[u] = rsqrtf(wave_sum_dpp(s2[u]) * (1.0f / DM) + LN_EPS);
#pragma unroll
        for (int j = 0; j < 4; ++j) { const f32x4 g0 = ((const f32x4*)g)[2 * (c.lane + 64 * j)], g1 = ((const f32x4*)g)[2 * (c.lane + 64 * j) + 1];
            const f32x4 b0 = ((const f32x4*)bta)[2 * (c.lane + 64 * j)], b1 = ((const f32x4*)bta)[2 * (c.lane + 64 * j) + 1];
#pragma unroll
            for (int u = 0; u < 2; ++u) { float o[8];
#pragma unroll
                for (int e = 0; e < 4; ++e) { o[e] = v[u][8 * j + e] * rstd[u] * g0[e] + b0[e]; o[4 + e] = v[u][8 * j + 4 + e] * rstd[u] * g1[e] + b1[e]; }
                if (OUT_F32) { f32x4* op = (f32x4*)((float*)Ov + (size_t)(row0 + u * c.NGW) * DM) + 2 * (c.lane + 64 * j);
                    op[0] = (f32x4){o[0], o[1], o[2], o[3]}; op[1] = (f32x4){o[4], o[5], o[6], o[7]}; }
                else { u32x4 w; w.x = cvt_pk_bf16(o[0], o[1]); w.y = cvt_pk_bf16(o[2], o[3]); w.z = cvt_pk_bf16(o[4], o[5]); w.w = cvt_pk_bf16(o[6], o[7]);
                    ((u32x4*)((bf16_t*)Ov + (size_t)(row0 + u * c.NGW) * DM))[c.lane + 64 * j] = w; } } }
    }
}

constexpr int N_PHASES = 11;
constexpr int LDS_BYTES = 8 * SLOT + 2 * YBUF;

#ifndef PROBE_REP_PHASE
#define PROBE_REP_PHASE -1
#endif
#define PHASE(n) if (a.ph_lo <= (n) && (n) < a.ph_hi) for (int rep_ = 0; rep_ < ((n) == PROBE_REP_PHASE ? 2 : 1); ++rep_)
#define SEAM(n) do { if (a.ph_lo < (n) && (n) < a.ph_hi) xcd_barrier(xb); __syncthreads(); } while (0)
__global__ void __launch_bounds__(512, 2) fwd_megakernel(Args a) {
    extern __shared__ __attribute__((aligned(16))) unsigned char smem[];
    LAS unsigned char* lds = (LAS unsigned char*)smem;
    const int G = gridDim.x, bid = blockIdx.x;
    __shared__ uint4 xb_words;
    if (threadIdx.x == 0) xb_words = make_uint4(0u, 0u, 0u, 0u);
    __syncthreads();
    XcdBarrier xb; xb.bar = (unsigned*)(a.ws + WS_BAR); xb.x = 0; xb.st = (volatile LAS unsigned*)&xb_words;
    if (a.ph_hi - a.ph_lo > 1) xb = xcd_barrier_post((unsigned*)(a.ws + WS_BAR), (volatile LAS unsigned*)&xb_words);
    if (a.ph_hi > 1000) cg::this_grid().sync();
    PHASE(0) { Ctx c(a, lds); phase0(c); }
    SEAM(1);
    PHASE(1) {
        pg8::Order<0> S; S.init(NTOK, INP, G, bid, a.ws + WS_XB, DM, a.ws + WS_WINT, DM);
        pg8::EpiBf16 E{(bf16_t*)(a.ws + WS_PROJ), INP};
        pg8::gemm_phase(lds, DM, DM, DM, S, E);
        __syncthreads();
        if (G == 256 && bid >= 128) phase1_fill(a, lds, bid - 128, 128);
        else if (G != 256) phase1_fill(a, lds, bid, G); }
    SEAM(2);
    PHASE(2) { Ctx c(a, lds); phase2(c); }
    SEAM(3);
    PHASE(3) {
        pg8::Order<3> S; S.init(NTOK, 6144, G, bid, (unsigned char*)a.out + DO_ALORA, 512, a.ws + WS_WLT, 128);
        pg8::EpiLora E{(bf16_t*)(a.ws + WS_OUT5), (const float*)(a.ws + WS_BIAS), 0};
        pg8::gemm_phase(lds, 128, 512, 128, S, E); }
    __syncthreads();
    PHASE(3) {
        pg8::Order<0> S; S.init(NTOK, 1536, G, bid, (unsigned char*)a.out + DO_ALORA + 512, 512, a.ws + WS_WLT + 2 * MiB, 256);
        pg8::EpiLora E{(bf16_t*)(a.ws + WS_OUT5), (const float*)(a.ws + WS_BIAS), 4};
        pg8::gemm_phase(lds, 256, 512, 256, S, E); }
    __syncthreads();
    PHASE(3) {
        pg8::Order<0> S; S.init(1024, NTOK, G, bid, a.ws + WS_CDFT, 512, a.ws + WS_PROJ, INP);
        pg8::EpiCdft E{(bf16_t*)((unsigned char*)a.out + DO_FABT)};
        pg8::gemm_phase(lds, 512, 512, INP, S, E); }
    SEAM(4);
    PHASE(4) {
        if (bid >= 192) {
            pg8::Order<2> S; S.init(NTOK, 512, 64, bid - 192, a.ws + WS_DFTM, 4096, (unsigned char*)a.out + DO_FABT, 4096);
            pg8::EpiBf16 E{(bf16_t*)(a.ws + WS_AMIX), DM};
            pg8::gemm_phase(lds, 4096, 4096, 4096, S, E);
            __syncthreads();
            {
                const int lane = threadIdx.x & 63, wave = __builtin_amdgcn_readfirstlane(threadIdx.x >> 6);
                LAS float* scr = (LAS float*)(lds + wave * 16384);
                for (int it = (bid - 192) * 8 + wave; it < 88 * 64; it += 64 * 8) tr_item<0>(a.in[22], DFF, DM, (bf16_t*)((unsigned char*)a.out + DO_WDNT), DFF, scr, it, lane); }
        } else scan2_phase(a, lds); }
    SEAM(5);
    PHASE(5) { Ctx c(a, lds); post_phase(c); }
    SEAM(6);
    PHASE(6) {
        pg8::Order<0> S; S.init(NTOK, DM, G, bid, a.ws + WS_AMIX, DM, a.ws + WS_WOUTT, DM);
        pg8::EpiResToBf16 E{(bf16_t*)(a.ws + WS_H), a.in[0]};
        pg8::gemm_phase(lds, DM, DM, DM, S, E); }
    SEAM(7);
    PHASE(7) {
        Ctx c(a, lds);
        ln_bf16_phase<false>(c, (const bf16_t*)(a.ws + WS_H), a.ws + WS_HB, a.in[18], a.in[19]);
        LAS float* scr = (LAS float*)(lds + c.wave * 16384);
        for (int it = c.gw; it < 32 * 176; it += c.NGW) tr_item<1>(a.in[20], DM, DFF, (bf16_t*)(a.ws + WS_WGUT), DM, scr, it, c.lane);
        for (int it = c.gw; it < 32 * 176; it += c.NGW) tr_item<2>(a.in[21], DM, DFF, (bf16_t*)(a.ws + WS_WGUT), DM, scr, it, c.lane);
    }
    SEAM(8);
    PHASE(8) {
        pg8::Order<0> S; S.init(NTOK, 2 * DFF, G, bid, a.ws + WS_HB, DM, a.ws + WS_WGUT, DM);
        pg8::EpiSwiglu E{(bf16_t*)(a.ws + WS_FFA)};
        pg8::gemm_phase(lds, DM, DM, DM, S, E); }
    SEAM(9);
    PHASE(9) {
        pg8::Order<0> S; S.init(NTOK, DM, G, bid, a.ws + WS_FFA, DFF, (unsigned char*)a.out + DO_WDNT, DFF);
        pg8::EpiResBfToBf E{(bf16_t*)(a.ws + WS_H), (const bf16_t*)(a.ws + WS_HB)};
        pg8::gemm_phase(lds, DFF, DFF, DFF, S, E); }
    SEAM(10);
    PHASE(10) { Ctx c(a, lds); ln_bf16_phase<true>(c, (const bf16_t*)(a.ws + WS_H), a.out, a.in[23], a.in[24]); }
}

extern "C" void kernel_launch(void* const* d_in, const int* in_sizes, int n_in, void* d_out, int out_size, void* d_ws, size_t ws_size, hipStream_t stream) {
    static int grid = 0;
    if (grid == 0) {
        if (n_in != 25 || out_size != NTOK * DM || ws_size < WS_END) { fprintf(stderr, "kernel_launch: unexpected shapes (n_in %d out %d ws %zu need %zu)\n", n_in, out_size, ws_size, (size_t)WS_END); grid = -1; return; }
        int dev = 0, cus = 0, per_cu = 0;
        hipGetDevice(&dev); hipDeviceGetAttribute(&cus, hipDeviceAttributeMultiprocessorCount, dev);
        if (hipFuncSetAttribute((const void*)fwd_megakernel, hipFuncAttributeMaxDynamicSharedMemorySize, LDS_BYTES) != hipSuccess) { fprintf(stderr, "kernel_launch: hipFuncSetAttribute failed\n"); grid = -1; return; }
        hipOccupancyMaxActiveBlocksPerMultiprocessor(&per_cu, (const void*)fwd_megakernel, 512, LDS_BYTES);
        if (per_cu < 1) { fprintf(stderr, "kernel_launch: occupancy query says %d blocks per CU\n", per_cu); (void)hipGetLastError(); per_cu = 1; }
        grid = cus < 256 ? cus : 256;
    }
    if (grid < 0) return;
    Args a{};
    for (int i = 0; i < 25; ++i) a.in[i] = (const float*)d_in[i];
    a.out = (float*)d_out; a.ws = (unsigned char*)d_ws;
#if N_LAUNCH_MODE == 1
    if (hipMemsetAsync((unsigned char*)d_ws + WS_BAR, 0, XCD_BAR_WORDS * 4, stream) != hipSuccess) { fprintf(stderr, "kernel_launch: memset of the barrier words failed\n"); return; }
    a.ph_lo = 0; a.ph_hi = N_PHASES;
    void* args[] = {&a};
    hipError_t e = hipLaunchCooperativeKernel((const void*)fwd_megakernel, dim3(grid), dim3(512), args, LDS_BYTES, stream);
    if (e != hipSuccess) fprintf(stderr, "cooperative launch failed: %s (grid %d)\n", hipGetErrorString(e), grid);
#else
    for (int ph = 0; ph < N_PHASES; ++ph) { a.ph_lo = ph; a.ph_hi = ph + 1;
        hipLaunchKernelGGL(fwd_megakernel, dim3(grid), dim3(512), LDS_BYTES, stream, a); }
#endif
}
```
